# Optimizing an MI355X kernel written in HIP

```python
import math
import jax, jax.numpy as jnp
from jax import lax
import numpy as np

D_MODEL = 1024
BATCH = 8
SEQ = 4096
DEPTH = 2

GRID_W = 64
Q_BLOCK = 128
EPS = 1e-6
ROPE_THETA = 500000.0
AXIAL_THETA = 10000.0

MLA_HEADS = 8
MLA_Q_RANK = 192
MLA_KV_RANK = 128
MLA_NOPE_DIM = 64
MLA_ROPE_DIM = 32
MLA_V_DIM = 64

DIFF_HEADS = 4
DIFF_DIM = 64
DIFF_V_DIM = 2 * DIFF_DIM
DIFF_ROT = DIFF_DIM // 4

GQA_HEADS = 8
GQA_KV_HEADS = 2
GQA_GROUP = GQA_HEADS // GQA_KV_HEADS
GQA_DIM = 128

FFN_HIDDEN = -(-8 * D_MODEL // (3 * 256)) * 256

EVEN_IN = MLA_Q_RANK + MLA_KV_RANK + MLA_ROPE_DIM + 3 * DIFF_HEADS * DIFF_V_DIM
EVEN_MIX = MLA_HEADS * MLA_V_DIM + DIFF_HEADS * DIFF_V_DIM
ODD_IN = (GQA_HEADS + 2 * GQA_KV_HEADS) * GQA_DIM
ODD_MIX = GQA_HEADS * GQA_DIM
N_EVEN = (DEPTH + 1) // 2
N_ODD = DEPTH // 2

kernel_name = "hybrid_mla_diff_gqa_axial_encoder"


def rmsnorm(x, g):
    xf = x.astype(jnp.float32)
    y = xf * lax.rsqrt(jnp.mean(xf * xf, axis=-1, keepdims=True) + EPS)
    return y.astype(x.dtype) * g


def rope_cos_sin(pos, dim, theta):
    inv = theta ** (-jnp.arange(0, dim, 2, dtype=jnp.float32) / dim)
    ang = pos.astype(jnp.float32)[:, None] * inv[None, :]
    return jnp.cos(ang), jnp.sin(ang)


def apply_rope(x, cos, sin):
    half = x.shape[-1] // 2
    xf = x.astype(jnp.float32)
    x1, x2 = xf[..., :half], xf[..., half:]
    bshape = (cos.shape[0],) + (1,) * (x.ndim - 3) + (half,)
    c, s = cos.reshape(bshape), sin.reshape(bshape)
    return jnp.concatenate([x1 * c - x2 * s, x2 * c + x1 * s], axis=-1).astype(x.dtype)


def partial_rope(x, cos, sin, rot):
    return jnp.concatenate([apply_rope(x[..., :rot], cos, sin), x[..., rot:]], axis=-1)


def axial_rope(x, row, col):
    half = x.shape[-1] // 2
    cr, sr = rope_cos_sin(row, half, AXIAL_THETA)
    cc, sc = rope_cos_sin(col, half, AXIAL_THETA)
    return jnp.concatenate([apply_rope(x[..., :half], cr, sr),
                            apply_rope(x[..., half:], cc, sc)], axis=-1)


def to_blocks(t):
    b, s = t.shape[:2]
    return jnp.moveaxis(t.reshape(b, s // Q_BLOCK, Q_BLOCK, *t.shape[2:]), 1, 0)


def from_blocks(t):
    nb, b, qb = t.shape[:3]
    return jnp.moveaxis(t, 0, 1).reshape(b, nb * qb, *t.shape[3:])


def grouped_attention(q, k, v):
    scale = q.shape[-1] ** -0.5

    def one_block(qb):
        s = jnp.einsum('bqhgd,bkhd->bhgqk', qb, k).astype(jnp.float32) * scale
        p = jax.nn.softmax(s, axis=-1).astype(v.dtype)
        return jnp.einsum('bhgqk,bkhd->bqhgd', p, v)

    return from_blocks(lax.map(one_block, to_blocks(q)))


def diff_attention(q, k, v, lam):
    scale = q.shape[-1] ** -0.5
    lam = lam.astype(jnp.float32)

    def one_block(qb):
        s = jnp.einsum('bqhcd,bkhcd->bhcqk', qb, k).astype(jnp.float32) * scale
        p = jax.nn.softmax(s, axis=-1)
        w = (p[:, :, 0] - lam * p[:, :, 1]).astype(v.dtype)
        return jnp.einsum('bhqk,bkhe->bqhe', w, v)

    return from_blocks(lax.map(one_block, to_blocks(q)))


def even_mixer(h, pos, layer_idx, w_in, q_norm, w_uq, kv_norm, w_ukv,
               lq1, lk1, lq2, lk2, subln, w_out):
    b, s, _ = h.shape
    proj = h @ w_in
    c_q, c_kv, k_rope, qkv_d = jnp.split(
        proj, [MLA_Q_RANK, MLA_Q_RANK + MLA_KV_RANK,
               MLA_Q_RANK + MLA_KV_RANK + MLA_ROPE_DIM], axis=-1)

    q = (rmsnorm(c_q, q_norm) @ w_uq).reshape(b, s, MLA_HEADS, MLA_NOPE_DIM + MLA_ROPE_DIM)
    kv = (rmsnorm(c_kv, kv_norm) @ w_ukv).reshape(b, s, MLA_HEADS, MLA_NOPE_DIM + MLA_V_DIM)
    cos, sin = rope_cos_sin(pos, MLA_ROPE_DIM, ROPE_THETA)
    q = jnp.concatenate([q[..., :MLA_NOPE_DIM], apply_rope(q[..., MLA_NOPE_DIM:], cos, sin)], axis=-1)
    k_r = apply_rope(k_rope, cos, sin)
    k = jnp.concatenate([kv[..., :MLA_NOPE_DIM],
                         jnp.broadcast_to(k_r[:, :, None, :], (b, s, MLA_HEADS, MLA_ROPE_DIM))], axis=-1)
    v = kv[..., MLA_NOPE_DIM:]
    o_mla = grouped_attention(q[:, :, :, None, :], k, v).reshape(b, s, MLA_HEADS * MLA_V_DIM)

    qd, kd, vd = jnp.split(qkv_d, 3, axis=-1)
    qd = qd.reshape(b, s, DIFF_HEADS, 2, DIFF_DIM)
    kd = kd.reshape(b, s, DIFF_HEADS, 2, DIFF_DIM)
    vd = vd.reshape(b, s, DIFF_HEADS, DIFF_V_DIM)
    cp, sp = rope_cos_sin(pos, DIFF_ROT, ROPE_THETA)
    qd = partial_rope(qd, cp, sp, DIFF_ROT)
    kd = partial_rope(kd, cp, sp, DIFF_ROT)
    lam_init = 0.8 - 0.6 * math.exp(-0.3 * layer_idx)
    lam = (jnp.exp(jnp.sum(lq1.astype(jnp.float32) * lk1.astype(jnp.float32)))
           - jnp.exp(jnp.sum(lq2.astype(jnp.float32) * lk2.astype(jnp.float32))) + lam_init)
    o_d = diff_attention(qd, kd, vd, lam)
    o_d = (rmsnorm(o_d, subln) * (1.0 - lam_init)).reshape(b, s, DIFF_HEADS * DIFF_V_DIM)

    return jnp.concatenate([o_mla, o_d], axis=-1) @ w_out


def odd_mixer(h, row, col, w_qkv, q_norm, k_norm, w_out):
    b, s, _ = h.shape
    proj = h @ w_qkv
    q, k, v = jnp.split(proj, [GQA_HEADS * GQA_DIM, (GQA_HEADS + GQA_KV_HEADS) * GQA_DIM], axis=-1)
    q = rmsnorm(q.reshape(b, s, GQA_HEADS, GQA_DIM), q_norm)
    k = rmsnorm(k.reshape(b, s, GQA_KV_HEADS, GQA_DIM), k_norm)
    v = v.reshape(b, s, GQA_KV_HEADS, GQA_DIM)
    q = axial_rope(q, row, col)
    k = axial_rope(k, row, col)
    o = grouped_attention(q.reshape(b, s, GQA_KV_HEADS, GQA_GROUP, GQA_DIM), k, v)
    return o.reshape(b, s, ODD_MIX) @ w_out


def swiglu(h, w_gate, w_up, w_down):
    return (jax.nn.silu(h @ w_gate) * (h @ w_up)) @ w_down


def setup_inputs(seed: int = 0) -> dict:
    key = jax.random.key(seed)
    ks = jax.random.split(key, 23)

    def w(k, shape, fan_in):
        return jax.random.normal(k, shape, jnp.float32) * (fan_in ** -0.5)

    def gain(k, shape):
        return 1.0 + 0.02 * jax.random.normal(k, shape, jnp.float32)

    def small(k, shape):
        return 0.1 * jax.random.normal(k, shape, jnp.float32)

    return {
        "x": jax.random.normal(ks[0], (BATCH, SEQ, D_MODEL), jnp.float32),
        "e_attn_norm": gain(ks[1], (N_EVEN, D_MODEL)),
        "e_w_in": w(ks[2], (N_EVEN, D_MODEL, EVEN_IN), D_MODEL),
        "e_q_norm": gain(ks[3], (N_EVEN, MLA_Q_RANK)),
        "e_w_uq": w(ks[4], (N_EVEN, MLA_Q_RANK, MLA_HEADS * (MLA_NOPE_DIM + MLA_ROPE_DIM)), MLA_Q_RANK),
        "e_kv_norm": gain(ks[5], (N_EVEN, MLA_KV_RANK)),
        "e_w_ukv": w(ks[6], (N_EVEN, MLA_KV_RANK, MLA_HEADS * (MLA_NOPE_DIM + MLA_V_DIM)), MLA_KV_RANK),
        "e_lambda_q1": small(ks[7], (N_EVEN, DIFF_DIM)),
        "e_lambda_k1": small(ks[8], (N_EVEN, DIFF_DIM)),
        "e_lambda_q2": small(ks[9], (N_EVEN, DIFF_DIM)),
        "e_lambda_k2": small(ks[10], (N_EVEN, DIFF_DIM)),
        "e_subln": gain(ks[11], (N_EVEN, DIFF_V_DIM)),
        "e_w_out": w(ks[12], (N_EVEN, EVEN_MIX, D_MODEL), EVEN_MIX),
        "o_attn_norm": gain(ks[13], (N_ODD, D_MODEL)),
        "o_w_qkv": w(ks[14], (N_ODD, D_MODEL, ODD_IN), D_MODEL),
        "o_q_norm": gain(ks[15], (N_ODD, GQA_DIM)),
        "o_k_norm": gain(ks[16], (N_ODD, GQA_DIM)),
        "o_w_out": w(ks[17], (N_ODD, ODD_MIX, D_MODEL), ODD_MIX),
        "ffn_norm": gain(ks[18], (DEPTH, D_MODEL)),
        "w_gate": w(ks[19], (DEPTH, D_MODEL, FFN_HIDDEN), D_MODEL),
        "w_up": w(ks[20], (DEPTH, D_MODEL, FFN_HIDDEN), D_MODEL),
        "w_down": w(ks[21], (DEPTH, FFN_HIDDEN, D_MODEL), FFN_HIDDEN),
        "final_norm": gain(ks[22], (D_MODEL,)),
    }


def reference(x, e_attn_norm, e_w_in, e_q_norm, e_w_uq, e_kv_norm, e_w_ukv,
              e_lambda_q1, e_lambda_k1, e_lambda_q2, e_lambda_k2, e_subln, e_w_out,
              o_attn_norm, o_w_qkv, o_q_norm, o_k_norm, o_w_out,
              ffn_norm, w_gate, w_up, w_down, final_norm):
    s = x.shape[1]
    rows = s // GRID_W
    pos = jnp.arange(s, dtype=jnp.int32)
    row = jnp.repeat(jnp.arange(rows, dtype=jnp.int32), GRID_W)
    col = jnp.tile(jnp.arange(GRID_W, dtype=jnp.int32), rows)

    h = x
    for i in range(DEPTH):
        j = i // 2
        if i % 2 == 0:
            h = h + even_mixer(rmsnorm(h, e_attn_norm[j]), pos, i, e_w_in[j], e_q_norm[j],
                               e_w_uq[j], e_kv_norm[j], e_w_ukv[j], e_lambda_q1[j],
                               e_lambda_k1[j], e_lambda_q2[j], e_lambda_k2[j],
                               e_subln[j], e_w_out[j])
        else:
            h = h + odd_mixer(rmsnorm(h, o_attn_norm[j]), row, col, o_w_qkv[j],
                              o_q_norm[j], o_k_norm[j], o_w_out[j])
        h = h + swiglu(rmsnorm(h, ffn_norm[i]), w_gate[i], w_up[i], w_down[i])
    return rmsnorm(h, final_norm)
```

```cpp
#include <hip/hip_runtime.h>
#include <hip/hip_cooperative_groups.h>
#include <cstdio>
#include <cstdint>
namespace cg = cooperative_groups;
namespace pg8 {
#define PG8_LAS __attribute__((address_space(3)))
typedef unsigned short bf16_t;
typedef short bf16x8 __attribute__((ext_vector_type(8)));
typedef float f32x4 __attribute__((ext_vector_type(4)));
typedef unsigned u32x4 __attribute__((ext_vector_type(4)));
constexpr int BM = 256, BK = 64, HALF = 128, HTB = HALF * BK * 2  , STAGE_BYTES = 8 * HTB, NXCD = 8, WGM = 2;

__host__ __device__ __forceinline__ int lds_byte(int r, int c) { const int st = (r >> 4) * 2 + (c >> 5), rr = r & 15, cc = c & 31, ob = rr * 64 + cc * 2; return st * 1024 + (ob ^ (((ob >> 9) & 1) << 5)); }
__host__ __device__ __forceinline__ void stage_rc(int b, int& R, int& C) { const int st = b / 1024, sb = b % 1024, swz = sb ^ (((sb >> 9) & 1) << 5); R = (st >> 1) * 16 + swz / 64; C = (st & 1) * 32 + (swz % 64) / 2; }
__host__ __device__ __forceinline__ int perm32(int rho) { const int n = rho >> 4, i = rho & 15; return 8 * (i >> 2) + 4 * n + (i & 3); }

struct Unit { int pm, pn; };
struct Gemm { const bf16_t* A; const bf16_t* Bt; int lda, ldb, M, N, K; };

struct StaticOrder {
    int nM, nN, nwg, G, c;
    __host__ __device__ void init(int M, int N, int G_, int c_) { nM = M / BM; nN = N / BM; nwg = nM * nN; G = G_; c = c_; }
    __host__ __device__ bool next(int i, Unit& u) const {
        const long L = (long)i * G + c; if (L >= nwg) return false;
        int wgid = (int)L; { const int q = nwg / NXCD, r = nwg % NXCD, xcd = wgid % NXCD, off = wgid / NXCD; wgid = (xcd < r ? xcd * (q + 1) : r * (q + 1) + (xcd - r) * q) + off; }
        const int nig = WGM * nN, gid = wgid / nig, fm = gid * WGM, gsz = (nM - fm) < WGM ? (nM - fm) : WGM;
        u.pm = fm + ((wgid % nig) % gsz); u.pn = (wgid % nig) / gsz; return true;
    }
    __device__ __forceinline__ void a_ready(const Unit&) const {}
    __device__ __forceinline__ void done(const Unit&) const {}
};

__device__ __forceinline__ unsigned cvt_pk_bf16(float lo, float hi) { unsigned r; asm volatile("v_cvt_pk_bf16_f32 %0, %1, %2" : "=v"(r) : "v"(lo), "v"(hi)); return r; }

struct EpiBf16S {
    static constexpr bool PERM = true, AFTER_DRAIN = false;
    bf16_t* O; int ldc; const float* ssq; float inv_n;
    __device__ __forceinline__ void operator()(const f32x4 (&acc)[2][2][4][2], const Unit& u, int wr, int wc, int fr, int fq) const {
        const int row0 = u.pm * BM + wr * 64 + fr, col0 = u.pn * BM + wc * 32 + 8 * fq;
        float sv[2][4];
#pragma unroll
        for (int ai = 0; ai < 2; ++ai)
#pragma unroll
            for (int m = 0; m < 4; ++m) sv[ai][m] = ssq ? ssq[row0 + ai * HALF + m * 16] : 0.f;
        asm volatile("" ::: "memory");
#pragma unroll
        for (int ai = 0; ai < 2; ++ai)
#pragma unroll
            for (int m = 0; m < 4; ++m) { const int row = row0 + ai * HALF + m * 16; const float s = ssq ? rsqrtf(sv[ai][m] * inv_n + 1e-6f) : 1.f; bf16_t* rowp = O + (size_t)row * ldc + col0;
#pragma unroll
                for (int bj = 0; bj < 2; ++bj) { const f32x4 v0 = acc[ai][bj][m][0] * s, v1 = acc[ai][bj][m][1] * s;
                    u32x4 w; w.x = cvt_pk_bf16(v0[0], v0[1]); w.y = cvt_pk_bf16(v0[2], v0[3]); w.z = cvt_pk_bf16(v1[0], v1[1]); w.w = cvt_pk_bf16(v1[2], v1[3]);
                    *(u32x4*)(rowp + bj * HALF) = w; } }
    }
};
struct EpiInProj {
    static constexpr bool PERM = true, AFTER_DRAIN = false;
    bf16_t* O; int ldc; float* ssq2; int sstride; const float* ssqx; float inv_n;
    __device__ __forceinline__ void operator()(const f32x4 (&acc)[2][2][4][2], const Unit& u, int wr, int wc, int fr, int fq) const {
        const int row0 = u.pm * BM + wr * 64 + fr, col0 = u.pn * BM + wc * 32 + 8 * fq;
        float sv[2][4];
#pragma unroll
        for (int ai = 0; ai < 2; ++ai)
#pragma unroll
            for (int m = 0; m < 4; ++m) sv[ai][m] = ssqx[row0 + ai * HALF + m * 16];
        asm volatile("" ::: "memory");
#pragma unroll
        for (int ai = 0; ai < 2; ++ai)
#pragma unroll
            for (int m = 0; m < 4; ++m) { const int row = row0 + ai * HALF + m * 16; bf16_t* rowp = O + (size_t)row * ldc + col0; const float sx = rsqrtf(sv[ai][m] * inv_n + 1e-6f);
#pragma unroll
                for (int bj = 0; bj < 2; ++bj) { const f32x4 v0 = acc[ai][bj][m][0] * sx, v1 = acc[ai][bj][m][1] * sx;
                    u32x4 w; w.x = cvt_pk_bf16(v0[0], v0[1]); w.y = cvt_pk_bf16(v0[2], v0[3]); w.z = cvt_pk_bf16(v1[0], v1[1]); w.w = cvt_pk_bf16(v1[2], v1[3]);
                    *(u32x4*)(rowp + bj * HALF) = w; }
                if (u.pn < 2) {
                    const f32x4 a0 = acc[ai][0][m][0] * sx, a1 = acc[ai][0][m][1] * sx; float s = (a0[0] * a0[0] + a0[1] * a0[1]) + (a0[2] * a0[2] + a0[3] * a0[3]) + (a1[0] * a1[0] + a1[1] * a1[1]) + (a1[2] * a1[2] + a1[3] * a1[3]);
                    if (u.pn == 0) { const f32x4 b0 = acc[ai][1][m][0] * sx, b1 = acc[ai][1][m][1] * sx; s += (b0[0] * b0[0] + b0[1] * b0[1]) + (b0[2] * b0[2] + b0[3] * b0[3]) + (b1[0] * b1[0] + b1[1] * b1[1]) + (b1[2] * b1[2] + b1[3] * b1[3]); }
                    s += __shfl_xor(s, 16); s += __shfl_xor(s, 32);
                    if (fq == 0) atomicAdd(ssq2 + (size_t)u.pn * sstride + row, s);
                } }
    }
};
__device__ __forceinline__ float silu_mul(float g, float u) { return g * u * __builtin_amdgcn_rcpf(1.f + __builtin_amdgcn_exp2f(-1.4426950408889634f * g)); }
struct EpiSwiGLU {
    static constexpr bool PERM = true, AFTER_DRAIN = false;
    bf16_t* O; int ldc; const float* ssq; float inv_n;
    __device__ __forceinline__ void operator()(const f32x4 (&acc)[2][2][4][2], const Unit& u, int wr, int wc, int fr, int fq) const {
        const int row0 = u.pm * BM + wr * 64 + fr, col0 = u.pn * HALF + wc * 32 + 8 * fq;
        float sv[2][4];
#pragma unroll
        for (int ai = 0; ai < 2; ++ai)
#pragma unroll
            for (int m = 0; m < 4; ++m) sv[ai][m] = ssq[row0 + ai * HALF + m * 16];
        asm volatile("" ::: "memory");
#pragma unroll
        for (int ai = 0; ai < 2; ++ai)
#pragma unroll
            for (int m = 0; m < 4; ++m) { const int row = row0 + ai * HALF + m * 16; bf16_t* rowp = O + (size_t)row * ldc + col0; const float s = rsqrtf(sv[ai][m] * inv_n + 1e-6f);
                const f32x4 g0 = acc[ai][0][m][0] * s, g1 = acc[ai][0][m][1] * s, u0 = acc[ai][1][m][0] * s, u1 = acc[ai][1][m][1] * s;
                u32x4 w; w.x = cvt_pk_bf16(silu_mul(g0[0], u0[0]), silu_mul(g0[1], u0[1])); w.y = cvt_pk_bf16(silu_mul(g0[2], u0[2]), silu_mul(g0[3], u0[3]));
                w.z = cvt_pk_bf16(silu_mul(g1[0], u1[0]), silu_mul(g1[1], u1[1])); w.w = cvt_pk_bf16(silu_mul(g1[2], u1[2]), silu_mul(g1[3], u1[3]));
                *(u32x4*)rowp = w; }
    }
};
struct EpiResF32N {
    static constexpr bool PERM = false, AFTER_DRAIN = false;
    const float* res; float* out; int ldc; bf16_t* hb; float* ssq;
    __device__ __forceinline__ void operator()(const f32x4 (&acc)[2][2][4][2], const Unit& u, int wr, int wc, int fr, int fq) const {
        const int row0 = u.pm * BM + wr * 64 + fr, col0 = u.pn * BM + wc * 32 + 4 * fq;
        typedef unsigned u32x2 __attribute__((ext_vector_type(2)));
#pragma unroll
        for (int ai = 0; ai < 2; ++ai)
#pragma unroll
            for (int mp = 0; mp < 1; ++mp) { f32x4 r[4][2][2];
#pragma unroll
                for (int mm = 0; mm < 4; ++mm) { const size_t off = (size_t)(row0 + ai * HALF + mm * 16) * ldc + col0;
#pragma unroll
                    for (int bj = 0; bj < 2; ++bj)
#pragma unroll
                        for (int n = 0; n < 2; ++n) r[mm][bj][n] = *(const f32x4*)(res + off + bj * HALF + n * 16); }
                asm volatile("" ::: "memory");
#pragma unroll
                for (int mm = 0; mm < 4; ++mm) { const int m = mm, row = row0 + ai * HALF + m * 16; const size_t off = (size_t)row * ldc + col0; float s = 0.f;
#pragma unroll
                    for (int bj = 0; bj < 2; ++bj)
#pragma unroll
                        for (int n = 0; n < 2; ++n) { const f32x4 v = r[mm][bj][n] + acc[ai][bj][m][n]; *(f32x4*)(out + off + bj * HALF + n * 16) = v;
                            s += (v[0] * v[0] + v[1] * v[1]) + (v[2] * v[2] + v[3] * v[3]);
                            u32x2 w; w.x = cvt_pk_bf16(v[0], v[1]); w.y = cvt_pk_bf16(v[2], v[3]); *(u32x2*)(hb + off + bj * HALF + n * 16) = w; }
                    s += __shfl_xor(s, 16); s += __shfl_xor(s, 32);
                    if (fq == 0) atomicAdd(ssq + row, s); } }
    }
};
template <bool RF32> struct EpiResB {
    static constexpr bool PERM = false, AFTER_DRAIN = false;
    const float* resf; bf16_t* hb; int ldc; float* ssq;
    __device__ __forceinline__ void operator()(const f32x4 (&acc)[2][2][4][2], const Unit& u, int wr, int wc, int fr, int fq) const {
        const int row0 = u.pm * BM + wr * 64 + fr, col0 = u.pn * BM + wc * 32 + 4 * fq;
        typedef unsigned u32x2 __attribute__((ext_vector_type(2)));
#pragma unroll
        for (int ai = 0; ai < 2; ++ai) { f32x4 r[4][2][2];
#pragma unroll
            for (int m = 0; m < 4; ++m) { const size_t off = (size_t)(row0 + ai * HALF + m * 16) * ldc + col0;
#pragma unroll
                for (int bj = 0; bj < 2; ++bj)
#pragma unroll
                    for (int n = 0; n < 2; ++n) {
                        if constexpr (RF32) r[m][bj][n] = *(const f32x4*)(resf + off + bj * HALF + n * 16);
                        else { const u32x2 w = *(const u32x2*)(hb + off + bj * HALF + n * 16);
                            r[m][bj][n] = (f32x4){__uint_as_float(w.x << 16), __uint_as_float(w.x & 0xffff0000u), __uint_as_float(w.y << 16), __uint_as_float(w.y & 0xffff0000u)}; } } }
            asm volatile("" ::: "memory");
#pragma unroll
            for (int m = 0; m < 4; ++m) { const int row = row0 + ai * HALF + m * 16; const size_t off = (size_t)row * ldc + col0; float s = 0.f;
#pragma unroll
                for (int bj = 0; bj < 2; ++bj)
#pragma unroll
                    for (int n = 0; n < 2; ++n) { const f32x4 v = r[m][bj][n] + acc[ai][bj][m][n];
                        s += (v[0] * v[0] + v[1] * v[1]) + (v[2] * v[2] + v[3] * v[3]);
                        u32x2 w; w.x = cvt_pk_bf16(v[0], v[1]); w.y = cvt_pk_bf16(v[2], v[3]); *(u32x2*)(hb + off + bj * HALF + n * 16) = w; }
                s += __shfl_xor(s, 16); s += __shfl_xor(s, 32);
                if (fq == 0) atomicAdd(ssq + row, s); } }
    }
};
struct EpiResF32 {
    static constexpr bool PERM = false, AFTER_DRAIN = false;
    const float* res; float* out; int ldc;
    __device__ __forceinline__ void operator()(const f32x4 (&acc)[2][2][4][2], const Unit& u, int wr, int wc, int fr, int fq) const {
        const int row0 = u.pm * BM + wr * 64 + fr, col0 = u.pn * BM + wc * 32 + 4 * fq;
#pragma unroll
        for (int ai = 0; ai < 2; ++ai)
#pragma unroll
            for (int mp = 0; mp < 1; ++mp) { f32x4 r[4][2][2];
#pragma unroll
                for (int mm = 0; mm < 4; ++mm) { const size_t off = (size_t)(row0 + ai * HALF + mm * 16) * ldc + col0;
#pragma unroll
                    for (int bj = 0; bj < 2; ++bj)
#pragma unroll
                        for (int n = 0; n < 2; ++n) r[mm][bj][n] = *(const f32x4*)(res + off + bj * HALF + n * 16); }
                asm volatile("" ::: "memory");
#pragma unroll
                for (int mm = 0; mm < 4; ++mm) { const int m = mm; const size_t off = (size_t)(row0 + ai * HALF + m * 16) * ldc + col0;
#pragma unroll
                    for (int bj = 0; bj < 2; ++bj)
#pragma unroll
                        for (int n = 0; n < 2; ++n) *(f32x4*)(out + off + bj * HALF + n * 16) = r[mm][bj][n] + acc[ai][bj][m][n]; } }
    }
};


template <class Epi, class Sched, bool ALIGN_EPI = false, bool SP2 = false>
__device__ __forceinline__ void gemm_phase(PG8_LAS unsigned char* lds, const Gemm g, const Sched& S, const Epi& E) {
    const int tid = threadIdx.x, wid = __builtin_amdgcn_readfirstlane(tid >> 6), lane = tid & 63, wr = wid >> 2, wc = wid & 3, fr = lane & 15, fq = lane >> 4;
    const int K = g.K, nt = K / BK;
    unsigned voffA[2], voffB[2];
#pragma unroll
    for (int i = 0; i < 2; ++i) { int R, C; stage_rc(tid * 16 + i * 8192, R, C); const int Rb = Epi::PERM ? ((R & ~31) + perm32(R & 31)) : R;
        voffA[i] = (unsigned)(R * g.lda + C) * 2u; voffB[i] = (unsigned)(Rb * g.ldb + C) * 2u; }
    const size_t kstep = (size_t)(BK * 2);
    const size_t hstepA = (size_t)HALF * g.lda * 2, hstepB = (size_t)HALF * g.ldb * 2;
    const size_t tstepA = 2 * hstepA, tstepB = 2 * hstepB;
    const unsigned ldsw = (unsigned)wid * 1024u;
    const int aoff = lds_byte(wr * 64 + fr, fq * 8), boff = lds_byte(wc * 32 + fr, fq * 8);
#define PG8_SA(b, h) (((b) * 2 + (h)) * HTB)
#define PG8_SB(b, h) ((4 + (b) * 2 + (h)) * HTB)
#define PG8_STAGE(bufoff, gbase, voff) do { _Pragma("unroll") for (int _i = 0; _i < 2; ++_i) \
        __builtin_amdgcn_global_load_lds((const unsigned*)((const char*)(gbase) + (voff)[_i]), (PG8_LAS unsigned*)(lds + (bufoff) + ldsw + _i * 8192), 16, 0, 0); } while (0)
#define PG8_LDA(dst, b, h) do { _Pragma("unroll") for (int m = 0; m < 4; ++m) _Pragma("unroll") for (int k = 0; k < 2; ++k) dst[m][k] = *(const PG8_LAS bf16x8*)(lds + PG8_SA(b, h) + aoff + m * 2048 + k * 1024); } while (0)
#define PG8_LDB(dst, b, h) do { _Pragma("unroll") for (int n = 0; n < 2; ++n) _Pragma("unroll") for (int k = 0; k < 2; ++k) dst[n][k] = *(const PG8_LAS bf16x8*)(lds + PG8_SB(b, h) + boff + n * 2048 + k * 1024); } while (0)
#define PG8_MMA(ai, bj, At, Bt) do { __builtin_amdgcn_s_setprio(1); _Pragma("unroll") for (int m = 0; m < 4; ++m) _Pragma("unroll") for (int n = 0; n < 2; ++n) _Pragma("unroll") for (int k = 0; k < 2; ++k) \
        acc[ai][bj][m][n] = __builtin_amdgcn_mfma_f32_16x16x32_bf16(Bt[n][k], At[m][k], acc[ai][bj][m][n], 0, 0, 0); __builtin_amdgcn_s_setprio(0); } while (0)
#define PG8_WAIT_V(n) asm volatile("s_waitcnt vmcnt(" #n ")" ::: "memory")
#define PG8_WAIT_L(n) asm volatile("s_waitcnt lgkmcnt(" #n ")" ::: "memory")
#define PG8_BAR __builtin_amdgcn_s_barrier()
#define PG8_SCHED __builtin_amdgcn_sched_barrier(0)
    Unit cur, nxt; int ui = 0;
    if (!S.next(0, cur)) return;
    f32x4 acc[2][2][4][2];
#pragma unroll
    for (int a = 0; a < 2; ++a)
#pragma unroll
        for (int b = 0; b < 2; ++b)
#pragma unroll
            for (int m = 0; m < 4; ++m)
#pragma unroll
                for (int n = 0; n < 2; ++n) acc[a][b][m][n] = (f32x4){0.f, 0.f, 0.f, 0.f};
    bf16x8 At[4][2], B0[2][2], B1[2][2];
    const char* cA = (const char*)g.A + (size_t)cur.pm * tstepA; const char* cB = (const char*)g.Bt + (size_t)cur.pn * tstepB;
    S.a_ready(cur);
    if constexpr (SP2) {
        PG8_STAGE(PG8_SB(0, 0), cB, voffB); PG8_STAGE(PG8_SB(0, 1), cB + hstepB, voffB); PG8_STAGE(PG8_SA(0, 0), cA, voffA); PG8_STAGE(PG8_SA(0, 1), cA + hstepA, voffA);
        if (wr == 1) PG8_BAR;
        PG8_WAIT_V(2); PG8_BAR;
        PG8_STAGE(PG8_SB(1, 0), cB + kstep, voffB); PG8_STAGE(PG8_SA(1, 0), cA + kstep, voffA); PG8_STAGE(PG8_SB(1, 1), cB + hstepB + kstep, voffB);
        PG8_WAIT_V(6); PG8_BAR;
    } else {
        PG8_STAGE(PG8_SB(0, 0), cB, voffB); PG8_STAGE(PG8_SA(0, 0), cA, voffA); PG8_STAGE(PG8_SB(0, 1), cB + hstepB, voffB); PG8_STAGE(PG8_SA(0, 1), cA + hstepA, voffA);
        if (wr == 1) PG8_BAR;
        PG8_WAIT_V(4); PG8_BAR;
        PG8_STAGE(PG8_SB(1, 0), cB + kstep, voffB); PG8_STAGE(PG8_SA(1, 0), cA + kstep, voffA); PG8_STAGE(PG8_SB(1, 1), cB + hstepB + kstep, voffB);
        PG8_WAIT_V(6); PG8_BAR;
    }
    for (;;) {
        const bool has_next = S.next(ui + 1, nxt);
        const char* nA = has_next ? (const char*)g.A + (size_t)nxt.pm * tstepA : cA; const char* nB = has_next ? (const char*)g.Bt + (size_t)nxt.pn * tstepB : cB;
        for (int t = 0; t < nt; t += 2) {
            const bool last = (t == nt - 2);
            const char* a1 = cA + (size_t)(t + 1) * kstep;
            const char* a2 = last ? nA : cA + (size_t)(t + 2) * kstep; const char* b2 = last ? nB : cB + (size_t)(t + 2) * kstep;
            const char* a3 = a2 + kstep; const char* b3 = b2 + kstep;
            if (last && has_next) S.a_ready(nxt);
            if constexpr (SP2) {
            PG8_LDB(B0, 0, 0); PG8_LDB(B1, 0, 1); PG8_SCHED; PG8_LDA(At, 0, 0); PG8_STAGE(PG8_SA(1, 1), a1 + hstepA, voffA);
            PG8_WAIT_V(8); PG8_WAIT_L(0); PG8_BAR; PG8_MMA(0, 0, At, B0); PG8_MMA(0, 1, At, B1); PG8_BAR; PG8_SCHED;
            PG8_LDA(At, 0, 1); PG8_STAGE(PG8_SB(0, 0), b2, voffB); PG8_STAGE(PG8_SB(0, 1), b2 + hstepB, voffB); PG8_STAGE(PG8_SA(0, 0), a2, voffA);
            PG8_WAIT_V(8); PG8_WAIT_L(0); PG8_BAR; PG8_MMA(1, 0, At, B0); PG8_MMA(1, 1, At, B1); PG8_BAR; PG8_SCHED;
            PG8_LDB(B0, 1, 0); PG8_LDB(B1, 1, 1); PG8_SCHED; PG8_LDA(At, 1, 0); PG8_STAGE(PG8_SA(0, 1), a2 + hstepA, voffA);
            PG8_WAIT_V(8); PG8_WAIT_L(0); PG8_BAR; PG8_MMA(0, 0, At, B0); PG8_MMA(0, 1, At, B1); PG8_BAR; PG8_SCHED;
            PG8_LDA(At, 1, 1); PG8_STAGE(PG8_SB(1, 0), b3, voffB); PG8_STAGE(PG8_SB(1, 1), b3 + hstepB, voffB); PG8_STAGE(PG8_SA(1, 0), a3, voffA);
            PG8_WAIT_V(8); PG8_WAIT_L(0); PG8_BAR; PG8_MMA(1, 0, At, B0); PG8_MMA(1, 1, At, B1); PG8_BAR; PG8_SCHED;
            } else {
            PG8_LDB(B0, 0, 0); PG8_SCHED; PG8_LDA(At, 0, 0); PG8_STAGE(PG8_SA(1, 1), a1 + hstepA, voffA);
            PG8_WAIT_L(8); PG8_BAR; PG8_WAIT_L(0); PG8_MMA(0, 0, At, B0); PG8_BAR; PG8_SCHED;
            PG8_LDB(B1, 0, 1); PG8_STAGE(PG8_SB(0, 0), b2, voffB);
            PG8_BAR; PG8_WAIT_L(0); PG8_MMA(0, 1, At, B1); PG8_BAR;
            PG8_LDA(At, 0, 1); PG8_STAGE(PG8_SA(0, 0), a2, voffA);
            PG8_BAR; PG8_WAIT_L(0); PG8_MMA(1, 0, At, B0); PG8_BAR; PG8_SCHED;
            PG8_STAGE(PG8_SB(0, 1), b2 + hstepB, voffB);
            PG8_WAIT_V(6); PG8_BAR; PG8_MMA(1, 1, At, B1); PG8_BAR;
            PG8_LDB(B0, 1, 0); PG8_SCHED; PG8_LDA(At, 1, 0); PG8_STAGE(PG8_SA(0, 1), a2 + hstepA, voffA);
            PG8_WAIT_L(8); PG8_BAR; PG8_WAIT_L(0); PG8_MMA(0, 0, At, B0); PG8_BAR; PG8_SCHED;
            PG8_LDB(B1, 1, 1); PG8_STAGE(PG8_SB(1, 0), b3, voffB);
            PG8_BAR; PG8_WAIT_L(0); PG8_MMA(0, 1, At, B1); PG8_BAR;
            PG8_LDA(At, 1, 1); PG8_STAGE(PG8_SA(1, 0), a3, voffA);
            PG8_BAR; PG8_WAIT_L(0); PG8_MMA(1, 0, At, B0); PG8_BAR; PG8_SCHED;
            PG8_STAGE(PG8_SB(1, 1), b3 + hstepB, voffB);
            PG8_WAIT_V(6); PG8_BAR; PG8_MMA(1, 1, At, B1); PG8_BAR;
            }
        }
        if constexpr (ALIGN_EPI) { if (wr == 0) PG8_BAR; }
        if constexpr (!Epi::AFTER_DRAIN) { E(acc, cur, wr, wc, fr, fq); S.done(cur); }
        if (!has_next) break;
#pragma unroll
        for (int a = 0; a < 2; ++a)
#pragma unroll
            for (int b = 0; b < 2; ++b)
#pragma unroll
                for (int m = 0; m < 4; ++m)
#pragma unroll
                    for (int n = 0; n < 2; ++n) acc[a][b][m][n] = (f32x4){0.f, 0.f, 0.f, 0.f};
        cur = nxt; cA = nA; cB = nB; ++ui;
        if constexpr (ALIGN_EPI) { if (wr == 1) PG8_BAR; }
    }
    PG8_WAIT_V(0);
    if constexpr (!ALIGN_EPI) { if (wr == 0) PG8_BAR; }
    PG8_BAR;
    if constexpr (Epi::AFTER_DRAIN) { E.fused(acc, cur, wr, wc, fr, fq, lds, wid, lane); S.done(cur); }
#undef PG8_SA
#undef PG8_SB
#undef PG8_STAGE
#undef PG8_LDA
#undef PG8_LDB
#undef PG8_MMA
#undef PG8_WAIT_V
#undef PG8_WAIT_L
#undef PG8_BAR
#undef PG8_SCHED
}
}
namespace att {
typedef unsigned short bf16;
typedef short bf16x8 __attribute__((ext_vector_type(8)));
typedef short s16x4 __attribute__((ext_vector_type(4)));
typedef float f32x16 __attribute__((ext_vector_type(16)));
typedef float f32x4 __attribute__((ext_vector_type(4)));
typedef unsigned u32x4 __attribute__((ext_vector_type(4)));
constexpr int NW = 8, QBLK = 32, KVBLK = 64;
constexpr int KROW = 272  , SHM_V = 16384, SHM_K = 64 * KROW, SLOTB = SHM_V + SHM_K, LDS_WS = 3 * SLOTB, LDS_BYTES = LDS_WS + NW * 64 * 4;
#define KSWZ(row, colB) ((row) * 256 + ((colB) ^ (((row) & 15) << 4)))
#define SBAR() __builtin_amdgcn_sched_barrier(0)
__device__ __forceinline__ int crow(int r, int hi) { return (r & 3) + 8 * (r >> 2) + 4 * hi; }
__device__ __forceinline__ unsigned cvtpk(float lo, float hi) { unsigned r; asm volatile("v_cvt_pk_bf16_f32 %0, %1, %2" : "=v"(r) : "v"(lo), "v"(hi)); return r; }
__device__ __forceinline__ float bf2f(short b) { return __uint_as_float(((unsigned)(unsigned short)b) << 16); }
__device__ __forceinline__ bf16x8 ld8(const bf16* p) { return *reinterpret_cast<const bf16x8*>(p); }
__device__ __forceinline__ bf16x8 pack8(const float* x) { u32x4 w = {cvtpk(x[0], x[1]), cvtpk(x[2], x[3]), cvtpk(x[4], x[5]), cvtpk(x[6], x[7])}; return *reinterpret_cast<bf16x8*>(&w); }

__device__ __forceinline__ void partialSM(f32x16& p0, f32x16& p1, float& m_reg, float& mn, float& alpha, const float C, const float thr) {
  float pmax = p0[0];
#pragma unroll
  for (int r = 1; r < 16; ++r) pmax = fmaxf(pmax, p0[r]);
#pragma unroll
  for (int r = 0; r < 16; ++r) pmax = fmaxf(pmax, p1[r]);
  { auto rr = __builtin_amdgcn_permlane32_swap(__float_as_uint(pmax), __float_as_uint(pmax), false, false);
    pmax = fmaxf(__uint_as_float(rr[0]), __uint_as_float(rr[1])); }
  if (__builtin_expect(__all(pmax - m_reg <= thr), 1)) { mn = m_reg; alpha = 1.f; }
  else { mn = fmaxf(m_reg, pmax); alpha = __builtin_amdgcn_exp2f((m_reg - mn) * C); m_reg = mn; }
  float mnC = -mn * C;
#pragma unroll
  for (int r = 0; r < 16; ++r) p0[r] = fmaf(p0[r], C, mnC);
#pragma unroll
  for (int r = 0; r < 16; ++r) p1[r] = fmaf(p1[r], C, mnC);
#pragma unroll
  for (int r = 0; r < 16; ++r) p0[r] = __builtin_amdgcn_exp2f(p0[r]);
}
__device__ __forceinline__ void finishSM(f32x16& p0, f32x16& p1, float alpha, float& l_reg, bf16x8& pa0, bf16x8& pa1, bf16x8& pa2, bf16x8& pa3) {
#pragma unroll
  for (int r = 0; r < 16; ++r) p1[r] = __builtin_amdgcn_exp2f(p1[r]);
  float ps = 0;
#pragma unroll
  for (int r = 0; r < 16; ++r) ps += p0[r];
#pragma unroll
  for (int r = 0; r < 16; ++r) ps += p1[r];
  { auto rr = __builtin_amdgcn_permlane32_swap(__float_as_uint(ps), __float_as_uint(ps), false, false);
    ps = __uint_as_float(rr[0]) + __uint_as_float(rr[1]); }
  l_reg = l_reg * alpha + ps;
#define PK4(P, BASE, OUT) do { unsigned a0 = cvtpk(P[BASE + 0], P[BASE + 1]), a1 = cvtpk(P[BASE + 2], P[BASE + 3]);   \
    unsigned b0 = cvtpk(P[BASE + 4], P[BASE + 5]), b1 = cvtpk(P[BASE + 6], P[BASE + 7]);                              \
    auto r0 = __builtin_amdgcn_permlane32_swap(a0, b0, false, false); auto r1 = __builtin_amdgcn_permlane32_swap(a1, b1, false, false); \
    u32x4 w = {r0[0], r1[0], r0[1], r1[1]}; OUT = *reinterpret_cast<bf16x8*>(&w); } while (0)
  PK4(p0, 0, pa0); PK4(p0, 8, pa1); PK4(p1, 0, pa2); PK4(p1, 8, pa3);
#undef PK4
}
template <int NQ>
__device__ __forceinline__ void qkt(f32x16& p0, f32x16& p1, const char* Ks, const bf16x8* qr, int r32, int hi) {
  p0 = f32x16{}; p1 = f32x16{};
#pragma unroll
  for (int d0 = 0; d0 < NQ; ++d0) { int cb = (d0 * 16 + hi * 8) * 2;
    bf16x8 b0 = *reinterpret_cast<const bf16x8*>(Ks + KSWZ(r32, cb));
    bf16x8 b1 = *reinterpret_cast<const bf16x8*>(Ks + KSWZ(32 + r32, cb));
    p0 = __builtin_amdgcn_mfma_f32_32x32x16_bf16(b0, qr[d0], p0, 0, 0, 0);
    p1 = __builtin_amdgcn_mfma_f32_32x32x16_bf16(b1, qr[d0], p1, 0, 0, 0); }
}
template <int NSUB> __device__ __forceinline__ int v_st(int k, int c) { const int kk = (k & ~0xC) | ((k & 4) << 1) | ((k & 8) >> 1); return ((kk >> 3) * NSUB + (c >> 5)) * 512 + ((kk & 7) * 32 + (c & 31)) * 2; }
__device__ __forceinline__ int v_rd_base(int lane) { return ((lane & 3) << 3) | (((lane >> 2) & 3) << 6) | (((lane >> 4) & 1) << 5) | (((lane >> 5) & 1) << 8); }
template <int NSUB> constexpr int v_rd_off(int d0, int ks, int half) { return ((2 * ks + half) * NSUB + d0) * 512; }
template <int OFF> __device__ __forceinline__ s16x4 tr_read(int vb) {
  s16x4 r; asm volatile("ds_read_b64_tr_b16 %0, %1 offset:%2" : "=&v"(r) : "v"(vb), "i"(OFF) : "memory"); return r;
}
template <int NSUB, int D0> __device__ __forceinline__ void pv_one(f32x16& od, int vb, bf16x8 pa0, bf16x8 pa1, bf16x8 pa2, bf16x8 pa3) {
  const s16x4 l0 = tr_read<v_rd_off<NSUB>(D0, 0, 0)>(vb), h0 = tr_read<v_rd_off<NSUB>(D0, 0, 1)>(vb), l1 = tr_read<v_rd_off<NSUB>(D0, 1, 0)>(vb), h1 = tr_read<v_rd_off<NSUB>(D0, 1, 1)>(vb);
  const s16x4 l2 = tr_read<v_rd_off<NSUB>(D0, 2, 0)>(vb), h2 = tr_read<v_rd_off<NSUB>(D0, 2, 1)>(vb), l3 = tr_read<v_rd_off<NSUB>(D0, 3, 0)>(vb), h3 = tr_read<v_rd_off<NSUB>(D0, 3, 1)>(vb);
  asm volatile("s_waitcnt lgkmcnt(0)" ::: "memory"); SBAR();
#define PK(L, H) (bf16x8){L[0], L[1], L[2], L[3], H[0], H[1], H[2], H[3]}
  od = __builtin_amdgcn_mfma_f32_32x32x16_bf16(pa0, PK(l0, h0), od, 0, 0, 0);
  od = __builtin_amdgcn_mfma_f32_32x32x16_bf16(pa1, PK(l1, h1), od, 0, 0, 0);
  od = __builtin_amdgcn_mfma_f32_32x32x16_bf16(pa2, PK(l2, h2), od, 0, 0, 0);
  od = __builtin_amdgcn_mfma_f32_32x32x16_bf16(pa3, PK(l3, h3), od, 0, 0, 0);
#undef PK
}
template <int NSUB> __device__ __forceinline__ void pv_d0(f32x16* o, int vb, bf16x8 pa0, bf16x8 pa1, bf16x8 pa2, bf16x8 pa3) {
  pv_one<NSUB, 0>(o[0], vb, pa0, pa1, pa2, pa3); pv_one<NSUB, 1>(o[1], vb, pa0, pa1, pa2, pa3);
  if constexpr (NSUB == 4) { pv_one<NSUB, 2>(o[2], vb, pa0, pa1, pa2, pa3); pv_one<NSUB, 3>(o[3], vb, pa0, pa1, pa2, pa3); }
}


#define PK4(P, BASE, OUT) do { unsigned a0 = cvtpk(P[BASE + 0], P[BASE + 1]), a1 = cvtpk(P[BASE + 2], P[BASE + 3]);   \
    unsigned b0 = cvtpk(P[BASE + 4], P[BASE + 5]), b1 = cvtpk(P[BASE + 6], P[BASE + 7]);                              \
    auto r0 = __builtin_amdgcn_permlane32_swap(a0, b0, false, false); auto r1 = __builtin_amdgcn_permlane32_swap(a1, b1, false, false); \
    u32x4 w = {r0[0], r1[0], r0[1], r1[1]}; OUT = *reinterpret_cast<bf16x8*>(&w); } while (0)
struct FinSt { float ps0, ps1; bf16x8 pa0, pa1, pa2, pa3; };
template <int CH> __device__ __forceinline__ void fin_chunk(f32x16& y0, f32x16& y1, FinSt& f) {
  if constexpr (CH < 4) {
#pragma unroll
    for (int j = 0; j < 4; ++j) y1[4 * CH + j] = __builtin_amdgcn_exp2f(y1[4 * CH + j]);
    f.ps0 += y0[4 * CH] + y0[4 * CH + 1]; f.ps1 += y0[4 * CH + 2] + y0[4 * CH + 3];
    if constexpr (CH == 0) PK4(y0, 0, f.pa0);
    if constexpr (CH == 1) PK4(y0, 8, f.pa1);
  } else {
    constexpr int c = CH - 4;
    f.ps0 += y1[4 * c] + y1[4 * c + 1]; f.ps1 += y1[4 * c + 2] + y1[4 * c + 3];
    if constexpr (CH == 4) PK4(y1, 0, f.pa2);
    if constexpr (CH == 6) PK4(y1, 8, f.pa3);
  }
}
template <int LO, int HI> __device__ __forceinline__ void fin_range(f32x16& y0, f32x16& y1, FinSt& f) {
  if constexpr (LO < HI) { fin_chunk<LO>(y0, y1, f); fin_range<LO + 1, HI>(y0, y1, f); }
}
template <int D0, int NQ, bool FIN>
__device__ __forceinline__ void qk_steps(f32x16& x0, f32x16& x1, bf16x8 kc0, bf16x8 kc1, const char* Ks, const bf16x8* qr, int r32, int hi, f32x16& y0, f32x16& y1, FinSt& f, const f32x16& cneg) {
  if constexpr (D0 < NQ) {
    bf16x8 kn0 = kc0, kn1 = kc1;
    if constexpr (D0 + 1 < NQ) { kn0 = *reinterpret_cast<const bf16x8*>(Ks + (D0 + 1) * 32); kn1 = *reinterpret_cast<const bf16x8*>(Ks + (D0 + 1) * 32 + 32 * KROW); }
    if constexpr (D0 == 0) { x0 = __builtin_amdgcn_mfma_f32_32x32x16_bf16(kc0, qr[0], cneg, 0, 0, 0); x1 = __builtin_amdgcn_mfma_f32_32x32x16_bf16(kc1, qr[0], cneg, 0, 0, 0); }
    else { x0 = __builtin_amdgcn_mfma_f32_32x32x16_bf16(kc0, qr[D0], x0, 0, 0, 0); x1 = __builtin_amdgcn_mfma_f32_32x32x16_bf16(kc1, qr[D0], x1, 0, 0, 0); }
    if constexpr (FIN) {
      fin_range<(D0 * 8) / NQ, ((D0 + 1) * 8) / NQ>(y0, y1, f);
      constexpr int NV = 6 * (((D0 + 1) * 8) / NQ - (D0 * 8) / NQ);
      __builtin_amdgcn_sched_group_barrier(0x008, 1, 0); __builtin_amdgcn_sched_group_barrier(0x002, NV, 0);
      __builtin_amdgcn_sched_group_barrier(0x008, 1, 0); __builtin_amdgcn_sched_group_barrier(0x002, 2 * NV, 0);
    }
    SBAR();
    qk_steps<D0 + 1, NQ, FIN>(x0, x1, kn0, kn1, Ks, qr, r32, hi, y0, y1, f, cneg);
  }
}
template <int NQ, bool FIN>
__device__ __forceinline__ void qk_fin(f32x16& x0, f32x16& x1, const char* Ks, const bf16x8* qr, int r32, int hi, f32x16& y0, f32x16& y1, FinSt& f, const f32x16& cneg) {
  const bf16x8 k0 = *reinterpret_cast<const bf16x8*>(Ks), k1 = *reinterpret_cast<const bf16x8*>(Ks + 32 * KROW);
  qk_steps<0, NQ, FIN>(x0, x1, k0, k1, Ks, qr, r32, hi, y0, y1, f, cneg);
}
struct PsmSt { float alpha; };
template <int CH, bool FIRST> __device__ __forceinline__ void psm_chunk(f32x16& x0, f32x16& x1, float& Mx, f32x16& cneg, PsmSt& q, const float thr) {
  if constexpr (CH == 0) {
    float pm = x0[0];
#pragma unroll
    for (int r = 1; r < 16; ++r) pm = fmaxf(pm, x0[r]);
#pragma unroll
    for (int r = 0; r < 16; ++r) pm = fmaxf(pm, x1[r]);
    { auto rr = __builtin_amdgcn_permlane32_swap(__float_as_uint(pm), __float_as_uint(pm), false, false); pm = fmaxf(__uint_as_float(rr[0]), __uint_as_float(rr[1])); }
    q.alpha = 1.f;
    const bool keep = FIRST ? false : __all(pm <= thr);
    if (!keep) {
      const float d = FIRST ? pm : fmaxf(pm, 0.f);
      q.alpha = FIRST ? 0.f : __builtin_amdgcn_exp2f(-d); Mx += d;
#pragma unroll
      for (int r = 0; r < 16; ++r) { x0[r] -= d; x1[r] -= d; cneg[r] -= d; }
    }
  } else if constexpr (CH == 1) {
#pragma unroll
    for (int r = 0; r < 4; ++r) x0[r] = __builtin_amdgcn_exp2f(x0[r]);
  } else if constexpr (CH == 2) {
#pragma unroll
    for (int r = 4; r < 10; ++r) x0[r] = __builtin_amdgcn_exp2f(x0[r]);
  } else {
#pragma unroll
    for (int r = 10; r < 16; ++r) x0[r] = __builtin_amdgcn_exp2f(x0[r]);
  }
}
template <int LO, int HI, bool FIRST> __device__ __forceinline__ void psm_range(f32x16& x0, f32x16& x1, float& Mx, f32x16& cneg, PsmSt& q, const float thr) {
  if constexpr (LO < HI) { psm_chunk<LO, FIRST>(x0, x1, Mx, cneg, q, thr); psm_range<LO + 1, HI, FIRST>(x0, x1, Mx, cneg, q, thr); }
}
template <int K, int NSUB, bool PSM>
__device__ __forceinline__ void pv_blocks(f32x16* o, int vb, const FinSt& f, f32x16& x0, f32x16& x1, float& Mx, f32x16& cneg, PsmSt& q, const float thr,
                                          s16x4 l0, s16x4 h0, s16x4 l1, s16x4 h1, s16x4 l2, s16x4 h2, s16x4 l3, s16x4 h3) {
  if constexpr (K < NSUB) {
    asm volatile("s_waitcnt lgkmcnt(0)" ::: "memory"); SBAR();
#define PK(L, H) (bf16x8){L[0], L[1], L[2], L[3], H[0], H[1], H[2], H[3]}
    o[K] = __builtin_amdgcn_mfma_f32_32x32x16_bf16(f.pa0, PK(l0, h0), o[K], 0, 0, 0);
    o[K] = __builtin_amdgcn_mfma_f32_32x32x16_bf16(f.pa1, PK(l1, h1), o[K], 0, 0, 0);
    s16x4 n0 = l0, n1 = h0, n2 = l1, n3 = h1, n4 = l2, n5 = h2, n6 = l3, n7 = h3;
    if constexpr (K + 1 < NSUB) { n0 = tr_read<v_rd_off<NSUB>(K + 1, 0, 0)>(vb); n1 = tr_read<v_rd_off<NSUB>(K + 1, 0, 1)>(vb); n2 = tr_read<v_rd_off<NSUB>(K + 1, 1, 0)>(vb); n3 = tr_read<v_rd_off<NSUB>(K + 1, 1, 1)>(vb); }
    o[K] = __builtin_amdgcn_mfma_f32_32x32x16_bf16(f.pa2, PK(l2, h2), o[K], 0, 0, 0);
    o[K] = __builtin_amdgcn_mfma_f32_32x32x16_bf16(f.pa3, PK(l3, h3), o[K], 0, 0, 0);
    if constexpr (K + 1 < NSUB) { n4 = tr_read<v_rd_off<NSUB>(K + 1, 2, 0)>(vb); n5 = tr_read<v_rd_off<NSUB>(K + 1, 2, 1)>(vb); n6 = tr_read<v_rd_off<NSUB>(K + 1, 3, 0)>(vb); n7 = tr_read<v_rd_off<NSUB>(K + 1, 3, 1)>(vb); }
#undef PK
    if constexpr (PSM) {
      psm_range<(K * 4) / NSUB, ((K + 1) * 4) / NSUB, false>(x0, x1, Mx, cneg, q, thr);
      asm volatile("" : "+v"(x0), "+v"(x1));
      constexpr int NV = (NSUB == 4) ? 5 : 10;
      __builtin_amdgcn_sched_group_barrier(0x008, 1, 0); __builtin_amdgcn_sched_group_barrier(0x002, NV, 0);
      __builtin_amdgcn_sched_group_barrier(0x008, 1, 0); __builtin_amdgcn_sched_group_barrier(0x002, NV, 0);
      __builtin_amdgcn_sched_group_barrier(0x008, 1, 0); __builtin_amdgcn_sched_group_barrier(0x002, NV, 0);
      __builtin_amdgcn_sched_group_barrier(0x008, 1, 0); __builtin_amdgcn_sched_group_barrier(0x002, 2 * NV, 0);
    }
    pv_blocks<K + 1, NSUB, PSM>(o, vb, f, x0, x1, Mx, cneg, q, thr, n0, n1, n2, n3, n4, n5, n6, n7);
  }
}
template <int NSUB, bool PSM>
__device__ __forceinline__ void pv_all(f32x16* o, int vb, const FinSt& f, f32x16& x0, f32x16& x1, float& Mx, f32x16& cneg, PsmSt& q, const float thr) {
  const s16x4 l0 = tr_read<v_rd_off<NSUB>(0, 0, 0)>(vb), h0 = tr_read<v_rd_off<NSUB>(0, 0, 1)>(vb), l1 = tr_read<v_rd_off<NSUB>(0, 1, 0)>(vb), h1 = tr_read<v_rd_off<NSUB>(0, 1, 1)>(vb);
  const s16x4 l2 = tr_read<v_rd_off<NSUB>(0, 2, 0)>(vb), h2 = tr_read<v_rd_off<NSUB>(0, 2, 1)>(vb), l3 = tr_read<v_rd_off<NSUB>(0, 3, 0)>(vb), h3 = tr_read<v_rd_off<NSUB>(0, 3, 1)>(vb);
  pv_blocks<0, NSUB, PSM>(o, vb, f, x0, x1, Mx, cneg, q, thr, l0, h0, l1, h1, l2, h2, l3, h3);
}
struct AU {
  const bf16* Q; int ldq;
  const bf16* K0; int ldk0;
  const bf16* K1; int ldk1;
  const bf16* V; int ldv;
  int seq, pos0;
  float C, thr;
  const float* tc; const float* ts;
  const float* qg;
  bf16* O; int ldo;
  float* scr;
  float lam, osc; const float* subln;
};

template <int DQK, int DV, int K0C, int QMODE, int OMODE>
__device__ __forceinline__ void attn_unit(const AU& a, char* lds) {
  constexpr int NQ = DQK / 16, NSUB = DV / 32;
  int tid_ = threadIdx.x; asm volatile("" : "+v"(tid_));
  const int tid = tid_, wid = tid >> 6, lane = tid & 63, r32 = lane & 31, hi = lane >> 5;
  char* V_lds = lds; char* K_lds = lds + SHM_V;
  float* ws = (float*)(lds + LDS_WS) + wid * 64; float* li_l = ws; float* al_l = ws + 32;
  float Mx = 0.f, l_reg = 0; f32x16 o[NSUB]; bf16x8 qr[NQ]; f32x16 cneg = f32x16{};
#pragma unroll
  for (int d = 0; d < NSUB; ++d) o[d] = f32x16{};
  const float C = a.C, thr = a.thr;
  constexpr bool K1ROW = (DQK == 64);
  const int sr = tid >> 4, sc8 = tid & 15; const bool kact = K1ROW || sc8 < DQK / 8, vact = sc8 < DV / 8;
  const int ksr = K1ROW ? (tid >> 3) : sr, ksc = K1ROW ? (tid & 7) : sc8;
  const int vst0 = v_st<NSUB>(sr, sc8 * 8), vst1 = v_st<NSUB>(32 + sr, sc8 * 8);
  const int kst0 = ksr * KROW + ksc * 16, kst1 = (32 + ksr) * KROW + ksc * 16;
  const char* kfb = K_lds + r32 * KROW + hi * 16;
  const bool k1 = (K0C < DQK / 8) && ksc >= K0C; const long kld = k1 ? a.ldk1 : a.ldk0;
  const bf16* kp = (k1 ? a.K1 + (ksc - K0C) * 8 : a.K0 + ksc * 8) + (long)ksr * kld; const bf16* vp = a.V + (long)sr * a.ldv + sc8 * 8; const long vld = a.ldv;
  const int vb0 = (int)(uintptr_t)V_lds + v_rd_base(lane);
  struct { bf16x8 vs0, vs1, ks0, ks1; } sr_[2];
#define SLOAD(i, k0) do { if (DV == 128 || vact) { sr_[i].vs0 = ld8(vp + (long)(k0) * vld); sr_[i].vs1 = ld8(vp + (long)((k0) + 32) * vld); } \
    if (DQK == 128 || kact) { sr_[i].ks0 = ld8(kp + (long)(k0) * kld); if (!K1ROW) sr_[i].ks1 = ld8(kp + (long)((k0) + 32) * kld); } } while (0)
#define SWRITE(off, i) do { if (DV == 128 || vact) { *(bf16x8*)(V_lds + (off) + vst0) = sr_[i].vs0; *(bf16x8*)(V_lds + (off) + vst1) = sr_[i].vs1; } \
    if (DQK == 128 || kact) { *(bf16x8*)(K_lds + (off) + kst0) = sr_[i].ks0; if (!K1ROW) *(bf16x8*)(K_lds + (off) + kst1) = sr_[i].ks1; } } while (0)
#define SWAIT() do { if (K1ROW) asm volatile("s_waitcnt vmcnt(3)" ::: "memory"); else asm volatile("s_waitcnt vmcnt(4)" ::: "memory"); } while (0)
  SLOAD(0, 0);
  {
    const bf16* Qrow = a.Q + (long)(wid * QBLK + r32) * a.ldq; const bf16* Qw = Qrow + hi * 8; const int pos = a.pos0 + wid * QBLK + r32;
    if constexpr (QMODE == 0) {
#pragma unroll
      for (int d0 = 0; d0 < 4; ++d0) { const bf16x8 rq = ld8(Qw + d0 * 16); float yq[8];
#pragma unroll
        for (int j = 0; j < 8; ++j) yq[j] = bf2f(rq[j]) * C;
        qr[d0] = pack8(yq); }
      const bf16x8 r1 = ld8(Qw + 64), r2 = ld8(Qw + 80); float y1[8], y2[8];
      const f32x4 c0 = *(const f32x4*)(a.tc + pos * 16 + hi * 8), c1 = *(const f32x4*)(a.tc + pos * 16 + hi * 8 + 4), s0 = *(const f32x4*)(a.ts + pos * 16 + hi * 8), s1 = *(const f32x4*)(a.ts + pos * 16 + hi * 8 + 4);
#pragma unroll
      for (int j = 0; j < 8; ++j) { const float x1 = bf2f(r1[j]), x2 = bf2f(r2[j]), c = j < 4 ? c0[j & 3] : c1[j & 3], s = j < 4 ? s0[j & 3] : s1[j & 3]; y1[j] = (x1 * c - x2 * s) * C; y2[j] = (x2 * c + x1 * s) * C; }
      qr[4] = pack8(y1); qr[5] = pack8(y2);
    } else if constexpr (QMODE == 1) {
      const bf16x8 r1 = ld8(Qrow), r2 = ld8(Qrow + 8); float y[8];
      const f32x4 c0 = *(const f32x4*)(a.tc + pos * 8), c1 = *(const f32x4*)(a.tc + pos * 8 + 4), s0 = *(const f32x4*)(a.ts + pos * 8), s1 = *(const f32x4*)(a.ts + pos * 8 + 4);
#pragma unroll
      for (int j = 0; j < 8; ++j) { const float x1 = bf2f(r1[j]), x2 = bf2f(r2[j]), c = j < 4 ? c0[j & 3] : c1[j & 3], s = j < 4 ? s0[j & 3] : s1[j & 3]; y[j] = (hi ? (x2 * c + x1 * s) : (x1 * c - x2 * s)) * C; }
      qr[0] = pack8(y);
#pragma unroll
      for (int d0 = 1; d0 < 4; ++d0) { const bf16x8 rq = ld8(Qw + d0 * 16); float yq[8];
#pragma unroll
        for (int j = 0; j < 8; ++j) yq[j] = bf2f(rq[j]) * C;
        qr[d0] = pack8(yq); }
    } else {
      bf16x8 raw[8]; float ss = 0.f;
#pragma unroll
      for (int d0 = 0; d0 < 8; ++d0) raw[d0] = ld8(Qw + d0 * 16);
#pragma unroll
      for (int d0 = 0; d0 < 8; ++d0)
#pragma unroll
        for (int j = 0; j < 8; ++j) { const float f = bf2f(raw[d0][j]); ss += f * f; }
      ss += __shfl_xor(ss, 32);
      const float rs = rsqrtf(ss * (1.f / 128.f) + 1e-6f) * C;
      const int rowp = pos >> 6, colp = pos & 63;
#pragma unroll
      for (int half = 0; half < 2; ++half)
#pragma unroll
        for (int b = 0; b < 2; ++b) { const int blk = half * 4 + b, fi = b * 16 + hi * 8; const float* tcp = a.tc + (half ? colp : rowp) * 32 + fi; const float* tsp = a.ts + (half ? colp : rowp) * 32 + fi;
          const f32x4 c0 = *(const f32x4*)tcp, c1 = *(const f32x4*)(tcp + 4), s0 = *(const f32x4*)tsp, s1 = *(const f32x4*)(tsp + 4);
          const f32x4 ga0 = *(const f32x4*)(a.qg + blk * 16 + hi * 8), ga1 = *(const f32x4*)(a.qg + blk * 16 + hi * 8 + 4), gb0 = *(const f32x4*)(a.qg + (blk + 2) * 16 + hi * 8), gb1 = *(const f32x4*)(a.qg + (blk + 2) * 16 + hi * 8 + 4);
          float y1[8], y2[8];
#pragma unroll
          for (int j = 0; j < 8; ++j) { const float x1 = bf2f(raw[blk][j]) * rs * (j < 4 ? ga0[j & 3] : ga1[j & 3]), x2 = bf2f(raw[blk + 2][j]) * rs * (j < 4 ? gb0[j & 3] : gb1[j & 3]);
            const float c = j < 4 ? c0[j & 3] : c1[j & 3], s = j < 4 ? s0[j & 3] : s1[j & 3]; y1[j] = x1 * c - x2 * s; y2[j] = x2 * c + x1 * s; }
          qr[blk] = pack8(y1); qr[blk + 2] = pack8(y2); }
    }
  }
#define RESC(al) do { if (__any((al) < 1.f)) { if (hi == 0) al_l[r32] = (al); asm volatile("s_waitcnt lgkmcnt(0)" ::: "memory"); \
    _Pragma("unroll") for (int d = 0; d < NSUB; ++d) _Pragma("unroll") for (int r = 0; r < 16; ++r) o[d][r] *= al_l[crow(r, hi)]; } } while (0)
  f32x16 pA0, pA1, pB0, pB1; float mnA, mnB, alA, alB; bf16x8 pa0, pa1, pa2, pa3; const int NT = a.seq / KVBLK;
  int o_prev = 0, o_cur = 0, o_next = SLOTB;
#define ADV() do { o_prev = o_cur; o_cur = o_next; o_next = (o_next == 2 * SLOTB) ? 0 : o_next + SLOTB; } while (0)
  FinSt fs; PsmSt qs; fs.ps0 = 0.f; fs.ps1 = 0.f;
#define FIN_TAIL(al) do { float ps = fs.ps0 + fs.ps1; auto rr = __builtin_amdgcn_permlane32_swap(__float_as_uint(ps), __float_as_uint(ps), false, false); \
    ps = __uint_as_float(rr[0]) + __uint_as_float(rr[1]); l_reg = l_reg * (al) + ps; fs.ps0 = 0.f; fs.ps1 = 0.f; } while (0)
  constexpr bool ONESLOT = (DQK == 128 && DV == 128);
  asm volatile("s_waitcnt vmcnt(0)" ::: "memory"); SWRITE(0, 0);
  if constexpr (ONESLOT) { SLOAD(0, KVBLK); } else { SLOAD(1, KVBLK); if (2 < NT) SLOAD(0, 2 * KVBLK); }
  __syncthreads();
  qk_fin<NQ, false>(pA0, pA1, kfb + o_cur, qr, r32, hi, pA0, pA1, fs, cneg); SBAR();
  if constexpr (ONESLOT) { SWRITE(o_next, 0); if (2 < NT) SLOAD(0, 2 * KVBLK); } else { SWAIT(); SWRITE(o_next, 1); if (3 < NT) SLOAD(1, 3 * KVBLK); } SBAR();
  psm_range<0, 4, true>(pA0, pA1, Mx, cneg, qs, thr); alA = qs.alpha; __syncthreads(); ADV();
  int t = 1;
  for (; t + 1 < NT; t += 2) {
    SBAR(); qk_fin<NQ, true>(pB0, pB1, kfb + o_cur, qr, r32, hi, pA0, pA1, fs, cneg); FIN_TAIL(alA); SBAR();
    if constexpr (ONESLOT) { SWRITE(o_next, 0); if (t + 2 < NT) SLOAD(0, (t + 2) * KVBLK); } else { SWAIT(); SWRITE(o_next, 0); if (t + 3 < NT) SLOAD(0, (t + 3) * KVBLK); } SBAR();
    pv_all<NSUB, true>(o, vb0 + o_prev, fs, pB0, pB1, Mx, cneg, qs, thr); alB = qs.alpha;
    RESC(alB); __syncthreads(); ADV();
    SBAR(); qk_fin<NQ, true>(pA0, pA1, kfb + o_cur, qr, r32, hi, pB0, pB1, fs, cneg); FIN_TAIL(alB); SBAR();
    if constexpr (ONESLOT) { if (t + 2 < NT) SWRITE(o_next, 0); if (t + 3 < NT) SLOAD(0, (t + 3) * KVBLK); } else { if (t + 2 < NT) { SWAIT(); SWRITE(o_next, 1); } if (t + 4 < NT) SLOAD(1, (t + 4) * KVBLK); } SBAR();
    pv_all<NSUB, true>(o, vb0 + o_prev, fs, pA0, pA1, Mx, cneg, qs, thr); alA = qs.alpha;
    RESC(alA); __syncthreads(); ADV();
  }
  SBAR(); qk_fin<NQ, true>(pB0, pB1, kfb + o_cur, qr, r32, hi, pA0, pA1, fs, cneg); FIN_TAIL(alA); SBAR();
  pv_all<NSUB, true>(o, vb0 + o_prev, fs, pB0, pB1, Mx, cneg, qs, thr); alB = qs.alpha;
  RESC(alB);
  fin_range<0, 8>(pB0, pB1, fs); FIN_TAIL(alB); SBAR();
  pv_all<NSUB, false>(o, vb0 + o_cur, fs, pB0, pB1, Mx, cneg, qs, thr);
#undef ADV
#undef FIN_TAIL
  if (hi == 0) li_l[r32] = l_reg; asm volatile("s_waitcnt lgkmcnt(0)" ::: "memory");
  float rli[16];
#pragma unroll
  for (int r = 0; r < 16; ++r) rli[r] = __builtin_amdgcn_rcpf(li_l[crow(r, hi)]);
  if constexpr (OMODE == 0) {
    bf16* Ow = a.O + (long)(wid * QBLK) * a.ldo;
#pragma unroll
    for (int r = 0; r < 16; ++r) { const int orow = crow(r, hi);
#pragma unroll
      for (int d0 = 0; d0 < NSUB; ++d0) Ow[(long)orow * a.ldo + d0 * 32 + r32] = (bf16)(cvtpk(o[d0][r] * rli[r], 0.f) & 0xffffu); }
  } else if constexpr (OMODE == 1) {
    f32x4* sp = (f32x4*)(a.scr + tid * 64);
#pragma unroll
    for (int d0 = 0; d0 < NSUB; ++d0)
#pragma unroll
      for (int r4 = 0; r4 < 4; ++r4) sp[d0 * 4 + r4] = (f32x4){o[d0][4 * r4] * rli[4 * r4], o[d0][4 * r4 + 1] * rli[4 * r4 + 1], o[d0][4 * r4 + 2] * rli[4 * r4 + 2], o[d0][4 * r4 + 3] * rli[4 * r4 + 3]};
  } else {
    bf16* Ow = a.O + (long)(wid * QBLK) * a.ldo; float ssq[16];
    const f32x4* sp = (const f32x4*)(a.scr + tid * 64);
#pragma unroll
    for (int r = 0; r < 16; ++r) ssq[r] = 0.f;
#pragma unroll
    for (int d0 = 0; d0 < NSUB; ++d0)
#pragma unroll
      for (int r4 = 0; r4 < 4; ++r4) { const f32x4 q = sp[d0 * 4 + r4];
#pragma unroll
        for (int j = 0; j < 4; ++j) { const int r = 4 * r4 + j; const float v = o[d0][r] * rli[r] - a.lam * q[j]; o[d0][r] = v; ssq[r] += v * v; } }
#pragma unroll
    for (int r = 0; r < 16; ++r) {
#pragma unroll
      for (int off = 1; off < 32; off <<= 1) ssq[r] += __shfl_xor(ssq[r], off);
      ssq[r] = rsqrtf(ssq[r] * (1.f / (float)DV) + 1e-6f) * a.osc; }
    float gn[NSUB];
#pragma unroll
    for (int d0 = 0; d0 < NSUB; ++d0) gn[d0] = a.subln[d0 * 32 + r32];
#pragma unroll
    for (int r = 0; r < 16; ++r) { const int orow = crow(r, hi);
#pragma unroll
      for (int d0 = 0; d0 < NSUB; ++d0) Ow[(long)orow * a.ldo + d0 * 32 + r32] = (bf16)(cvtpk(o[d0][r] * ssq[r] * gn[d0], 0.f) & 0xffffu); }
  }
  __syncthreads();
#undef SLOAD
#undef SWRITE
#undef SWAIT
#undef RESC
}
#undef PK4
#undef KSWZ
#undef SBAR
}
#define GAS __attribute__((address_space(1)))
#define LAS __attribute__((address_space(3)))
typedef unsigned short bf16;
typedef unsigned v4u __attribute__((ext_vector_type(4)));
typedef unsigned v2u __attribute__((ext_vector_type(2)));
typedef float f32x4 __attribute__((ext_vector_type(4)));
constexpr int NWAVES = 8;
constexpr int BATCH = 8, SEQ = 4096, DM = 1024, T = BATCH * SEQ, FF = 2816;
constexpr int PROJ_LD = 2048;
constexpr int QKV_LD = 1536;
constexpr float EPS = 1e-6f;
constexpr size_t MiB = 1u << 20;
constexpr size_t WS_CTL = 0, CTL_ZERO_BYTES = 65536;
constexpr size_t WS_TAB = 1 * MiB;
constexpr size_t TAB_AC = 0, TAB_AS = 262144, TAB_BC = 524288, TAB_BS = 655360, TAB_CC = 786432, TAB_CS = 794624;
constexpr size_t WS_SSQ = 2 * MiB;
constexpr size_t WS_WIN = 4 * MiB, WS_WUQ = 8 * MiB, WS_WUKV = 9 * MiB, WS_WEO = 10 * MiB, WS_WOQKV = 12 * MiB, WS_WOO = 15 * MiB;
constexpr size_t WS_WGU0 = 17 * MiB, WS_WGU1 = 28 * MiB, WS_WDN0 = 39 * MiB, WS_WDN1 = 45 * MiB, WS_KR = 51 * MiB;
constexpr size_t WS_XN = 64 * MiB, WS_PROJ = 128 * MiB, WS_QM = 256 * MiB, WS_KVM = 304 * MiB, WS_MIX = 368 * MiB, WS_ACT = 128 * MiB, WS_SCR = 432 * MiB, WS_END = 464 * MiB;
constexpr int LDS_BYTES = 147456;

__device__ __forceinline__ unsigned f2bf(float f) { unsigned u = __builtin_bit_cast(unsigned, f); return (u + 0x7fffu + ((u >> 16) & 1u)) >> 16; }
__device__ __forceinline__ unsigned pk2(float lo, float hi) { return f2bf(lo) | (f2bf(hi) << 16); }
__device__ __forceinline__ float bf2f(unsigned b) { return __uint_as_float(b << 16); }
__device__ __forceinline__ float wave_sum(float v) {
#pragma unroll
    for (int o = 1; o < 64; o <<= 1) v += __shfl_xor(v, o);
    return v;
}
#define LDS_WAIT() asm volatile("s_waitcnt lgkmcnt(0)" ::: "memory")

__device__ __forceinline__ void transpose_item(const float* W, int K, int N, bf16* WT, int ldk, int rowmap, const float* kg, LAS float* scr, int item, int lane) {
    const int nblk = N / 32, kb = item / nblk, nb = item % nblk, k0 = 64 * kb, n0 = 32 * nb;
    int r0 = n0;
    if (rowmap == 1) r0 = n0 < 192 ? n0 : (n0 < 352 ? 256 + (n0 - 192) : 512 + (n0 - 352));
    else if (rowmap == 2) r0 = 256 * (n0 >> 7) + (n0 & 127);
    else if (rowmap == 3) r0 = 256 * (n0 >> 7) + 128 + (n0 & 127);
    float wv[32];
#pragma unroll
    for (int i = 0; i < 32; ++i) { const int kk = 2 * i + (lane >> 5); wv[i] = W[(size_t)(k0 + kk) * N + n0 + (lane & 31)]; }
    if (kg) {
#pragma unroll
        for (int i = 0; i < 32; ++i) wv[i] *= kg[k0 + 2 * i + (lane >> 5)]; }
    asm volatile("" ::: "memory");
#pragma unroll
    for (int i = 0; i < 32; ++i) { const int kk = 2 * i + (lane >> 5); scr[kk * 33 + (lane & 31)] = wv[i]; }
    LDS_WAIT(); asm volatile("" ::: "memory");
    const int c = lane & 7;
#pragma unroll
    for (int j = 0; j < 4; ++j) { const int n = (lane >> 3) + 8 * j; const LAS float* s = scr + (8 * c) * 33 + n;
        v4u o; o.x = pk2(s[0 * 33], s[1 * 33]); o.y = pk2(s[2 * 33], s[3 * 33]); o.z = pk2(s[4 * 33], s[5 * 33]); o.w = pk2(s[6 * 33], s[7 * 33]);
        *(v4u*)(WT + (size_t)(r0 + n) * ldk + k0 + 8 * c) = o; }
    LDS_WAIT(); asm volatile("" ::: "memory");
}
__device__ __forceinline__ void rms_row_to_bf16(const float* xrow, const float* g, bf16* orow, int lane) {
    const f32x4* xr = (const f32x4*)xrow + lane; const f32x4* gr = (const f32x4*)g + lane;
    f32x4 v[4]; float s = 0.f;
#pragma unroll
    for (int j = 0; j < 4; ++j) { v[j] = xr[64 * j]; s += (v[j].x * v[j].x + v[j].y * v[j].y) + (v[j].z * v[j].z + v[j].w * v[j].w); }
    const float rs = rsqrtf(wave_sum(s) * (1.f / DM) + EPS);
    unsigned long long* o8 = (unsigned long long*)orow + lane;
#pragma unroll
    for (int j = 0; j < 4; ++j) { const f32x4 gg = gr[64 * j]; o8[64 * j] = (unsigned long long)pk2(v[j].x * rs * gg.x, v[j].y * rs * gg.y) | ((unsigned long long)pk2(v[j].z * rs * gg.z, v[j].w * rs * gg.w) << 32); }
}
__device__ __forceinline__ void rms_row_f32(float* xrow, const float* g, int lane) {
    f32x4* xr = (f32x4*)xrow + lane; const f32x4* gr = (const f32x4*)g + lane;
    f32x4 v[4]; float s = 0.f;
#pragma unroll
    for (int j = 0; j < 4; ++j) { v[j] = xr[64 * j]; s += (v[j].x * v[j].x + v[j].y * v[j].y) + (v[j].z * v[j].z + v[j].w * v[j].w); }
    const float rs = rsqrtf(wave_sum(s) * (1.f / DM) + EPS);
#pragma unroll
    for (int j = 0; j < 4; ++j) { const f32x4 gg = gr[64 * j]; xr[64 * j] = v[j] * rs * gg; }
}

__device__ __forceinline__ void rms_rows2_to_bf16(const float* xa, const float* xb, const float* g, bf16* oa, bf16* ob, int lane) {
    const f32x4* ra = (const f32x4*)xa + lane; const f32x4* rb = (const f32x4*)xb + lane; const f32x4* gr = (const f32x4*)g + lane;
    f32x4 va[4], vb[4]; float sa = 0.f, sb = 0.f;
#pragma unroll
    for (int j = 0; j < 4; ++j) { va[j] = ra[64 * j]; vb[j] = rb[64 * j]; }
#pragma unroll
    for (int j = 0; j < 4; ++j) { sa += (va[j].x * va[j].x + va[j].y * va[j].y) + (va[j].z * va[j].z + va[j].w * va[j].w); sb += (vb[j].x * vb[j].x + vb[j].y * vb[j].y) + (vb[j].z * vb[j].z + vb[j].w * vb[j].w); }
    const float rsa = rsqrtf(wave_sum(sa) * (1.f / DM) + EPS), rsb = rsqrtf(wave_sum(sb) * (1.f / DM) + EPS);
    unsigned long long* pa = (unsigned long long*)oa + lane; unsigned long long* pb = (unsigned long long*)ob + lane;
#pragma unroll
    for (int j = 0; j < 4; ++j) { const f32x4 gg = gr[64 * j];
        pa[64 * j] = (unsigned long long)pk2(va[j].x * rsa * gg.x, va[j].y * rsa * gg.y) | ((unsigned long long)pk2(va[j].z * rsa * gg.z, va[j].w * rsa * gg.w) << 32);
        pb[64 * j] = (unsigned long long)pk2(vb[j].x * rsb * gg.x, vb[j].y * rsb * gg.y) | ((unsigned long long)pk2(vb[j].z * rsb * gg.z, vb[j].w * rsb * gg.w) << 32); }
}
__device__ __forceinline__ void rms_rows2_f32(float* xa, float* xb, const float* g, int lane) {
    f32x4* ra = (f32x4*)xa + lane; f32x4* rb = (f32x4*)xb + lane; const f32x4* gr = (const f32x4*)g + lane;
    f32x4 va[4], vb[4]; float sa = 0.f, sb = 0.f;
#pragma unroll
    for (int j = 0; j < 4; ++j) { va[j] = ra[64 * j]; vb[j] = rb[64 * j]; }
#pragma unroll
    for (int j = 0; j < 4; ++j) { sa += (va[j].x * va[j].x + va[j].y * va[j].y) + (va[j].z * va[j].z + va[j].w * va[j].w); sb += (vb[j].x * vb[j].x + vb[j].y * vb[j].y) + (vb[j].z * vb[j].z + vb[j].w * vb[j].w); }
    const float rsa = rsqrtf(wave_sum(sa) * (1.f / DM) + EPS), rsb = rsqrtf(wave_sum(sb) * (1.f / DM) + EPS);
#pragma unroll
    for (int j = 0; j < 4; ++j) { const f32x4 gg = gr[64 * j]; ra[64 * j] = va[j] * rsa * gg; rb[64 * j] = vb[j] * rsb * gg; }
}
__device__ __forceinline__ void rms_rows4_to_bf16(const float* x, const float* g, bf16* o, int m, int stride, int lane) {
    f32x4 v[4][4]; float rs[4];
#pragma unroll
    for (int t = 0; t < 4; ++t) { const f32x4* r = (const f32x4*)(x + (size_t)(m + t * stride) * DM) + lane;
#pragma unroll
        for (int j = 0; j < 4; ++j) v[t][j] = r[64 * j]; }
    asm volatile("" ::: "memory");
#pragma unroll
    for (int t = 0; t < 4; ++t) { float s = 0.f;
#pragma unroll
        for (int j = 0; j < 4; ++j) s += (v[t][j].x * v[t][j].x + v[t][j].y * v[t][j].y) + (v[t][j].z * v[t][j].z + v[t][j].w * v[t][j].w);
        rs[t] = rsqrtf(wave_sum(s) * (1.f / DM) + EPS); }
    const f32x4* gr = (const f32x4*)g + lane;
#pragma unroll
    for (int j = 0; j < 4; ++j) { const f32x4 gg = gr[64 * j];
#pragma unroll
        for (int t = 0; t < 4; ++t) { unsigned long long* po = (unsigned long long*)(o + (size_t)(m + t * stride) * DM) + lane;
            po[64 * j] = (unsigned long long)pk2(v[t][j].x * rs[t] * gg.x, v[t][j].y * rs[t] * gg.y) | ((unsigned long long)pk2(v[t][j].z * rs[t] * gg.z, v[t][j].w * rs[t] * gg.w) << 32); } }
}
__device__ __forceinline__ void rows4_to_bf16_ssq(const float* x, bf16* o, float* ssq, int m, int stride, int lane) {
    f32x4 v[4][4];
#pragma unroll
    for (int t = 0; t < 4; ++t) { const f32x4* r = (const f32x4*)(x + (size_t)(m + t * stride) * DM) + lane;
#pragma unroll
        for (int j = 0; j < 4; ++j) v[t][j] = r[64 * j]; }
    asm volatile("" ::: "memory");
#pragma unroll
    for (int t = 0; t < 4; ++t) { float s = 0.f;
#pragma unroll
        for (int j = 0; j < 4; ++j) s += (v[t][j].x * v[t][j].x + v[t][j].y * v[t][j].y) + (v[t][j].z * v[t][j].z + v[t][j].w * v[t][j].w);
        s = wave_sum(s); if (lane == 0) ssq[m + t * stride] = s; }
#pragma unroll
    for (int j = 0; j < 4; ++j)
#pragma unroll
        for (int t = 0; t < 4; ++t) { unsigned long long* po = (unsigned long long*)(o + (size_t)(m + t * stride) * DM) + lane;
            po[64 * j] = (unsigned long long)pk2(v[t][j].x, v[t][j].y) | ((unsigned long long)pk2(v[t][j].z, v[t][j].w) << 32); }
}
#define XB_TMO      128
#define XB_XCNT(j)  (256  + 64 * (j))
#define XB_XSUB(j)  (1280 + 64 * (j))
#define XB_XGEN(j)  (2304 + 64 * (j))
#define XB_TOP      3328
#define XB_TOPGEN   3392
#define XCD_BAR_WORDS 3456
#define XB_SPIN_CAP (1u << 18)
#define LAS __attribute__((address_space(3)))

__device__ __forceinline__ unsigned xb_ld(unsigned* p)              { return __hip_atomic_load(p, __ATOMIC_RELAXED, __HIP_MEMORY_SCOPE_AGENT); }
__device__ __forceinline__ unsigned xb_add(unsigned* p, unsigned v) { return __hip_atomic_fetch_add(p, v, __ATOMIC_RELAXED, __HIP_MEMORY_SCOPE_AGENT); }
__device__ __forceinline__ unsigned xb_xcc_id() { return (unsigned)__builtin_amdgcn_s_getreg((3 << 11) | 20) & 0xFu; }
#define XB_SPIN(cond, bar) do { unsigned _sp = 0; while (cond) { __builtin_amdgcn_s_sleep(1); \
    if ((++_sp & 255u) == 0u) { if (xb_ld(&(bar)[XB_TMO])) break; if (_sp > XB_SPIN_CAP) { atomicAdd(&(bar)[XB_TMO], 1u); break; } } } } while (0)

struct XcdBarrier {
    unsigned* bar; unsigned x;
    volatile LAS unsigned* st;
};

__device__ __forceinline__ XcdBarrier xcd_barrier_post(unsigned* bar, volatile LAS unsigned* st) {
    XcdBarrier b; b.bar = bar; b.x = xb_xcc_id(); b.st = st;
    if (threadIdx.x == 0) (void)xb_add(&bar[XB_XCNT(b.x)], 1u);
    return b;
}
__device__ __forceinline__ void xcd_barrier_complete(unsigned* bar, unsigned x, unsigned& nloc, unsigned& nx) {
    const unsigned G = gridDim.x * gridDim.y * gridDim.z;
    unsigned sum, cnt, mine, sp = 0u;
    for (;;) {
        sum = 0u; cnt = 0u; mine = 0u;
#pragma unroll
        for (unsigned j = 0; j < 16; ++j) { const unsigned c = xb_ld(&bar[XB_XCNT(j)]); sum += c; cnt += (c > 0u) ? 1u : 0u; mine = (j == x) ? c : mine; }
        if (sum == G) break;
        __builtin_amdgcn_s_sleep(1);
        if ((++sp & 255u) == 0u) { if (xb_ld(&bar[XB_TMO])) break; if (sp > XB_SPIN_CAP) { atomicAdd(&bar[XB_TMO], 1u); break; } }
    }
    nloc = mine > 0u ? mine : 1u; nx = cnt > 0u ? cnt : 1u;
}

__device__ __forceinline__ void xcd_barrier(const XcdBarrier& b) {
    asm volatile("s_waitcnt vmcnt(0)" ::: "memory");
    __syncthreads();
    if (threadIdx.x == 0) {
        unsigned* bar = b.bar;
        __builtin_amdgcn_s_waitcnt(0);
        unsigned nloc = b.st[0], nx = b.st[1];
        if (nloc == 0u) { xcd_barrier_complete(bar, b.x, nloc, nx); b.st[0] = nloc; b.st[1] = nx; }
        const unsigned old = xb_add(&bar[XB_XSUB(b.x)], 1u);
        const unsigned gen = old / nloc;
        if (old + 1u == (gen + 1u) * nloc) {
            __builtin_amdgcn_fence(__ATOMIC_RELEASE, "agent");
            asm volatile("s_waitcnt vmcnt(0)" ::: "memory");
            const unsigned og = xb_add(&bar[XB_TOP], 1u);
            const unsigned tg = og / nx;
            if (og + 1u == (tg + 1u) * nx) xb_add(&bar[XB_TOPGEN], 1u);
            else XB_SPIN(xb_ld(&bar[XB_TOPGEN]) == tg, bar);
            __builtin_amdgcn_fence(__ATOMIC_ACQUIRE, "agent");
            xb_add(&bar[XB_XGEN(b.x)], 1u);
            asm volatile("s_waitcnt vmcnt(0)" ::: "memory");
        } else {
            XB_SPIN(xb_ld(&bar[XB_XGEN(b.x)]) == gen, bar);
            __builtin_amdgcn_fence(__ATOMIC_ACQUIRE, "agent");
            asm volatile("s_waitcnt vmcnt(0)" ::: "memory");
        }
    }
    __syncthreads();
}

struct Params { const float* in[23]; float* out; unsigned char* ws; int ph_lo, ph_hi, coop_keep, pad; };
constexpr int N_PHASES = 14;

__global__ void __launch_bounds__(NWAVES * 64, 2) fwd_mega(Params p) {
    extern __shared__ __attribute__((aligned(16))) unsigned char lds[];
    cg::grid_group grid = cg::this_grid();
    const int tid = threadIdx.x, lane = tid & 63, wave = __builtin_amdgcn_readfirstlane(tid >> 6);
    const int G = gridDim.x, bx = blockIdx.x;
    const int gw = bx * NWAVES + wave, NGW = G * NWAVES;
    unsigned char* ws = p.ws;
    LAS unsigned char* ldsl = (LAS unsigned char*)lds;
    const float* tAc = (const float*)(ws + WS_TAB + TAB_AC); const float* tAs = (const float*)(ws + WS_TAB + TAB_AS);
    const float* tBc = (const float*)(ws + WS_TAB + TAB_BC); const float* tBs = (const float*)(ws + WS_TAB + TAB_BS);
    const float* tCc = (const float*)(ws + WS_TAB + TAB_CC); const float* tCs = (const float*)(ws + WS_TAB + TAB_CS);
    float* ssq_q = (float*)(ws + WS_SSQ); float* ssq_kv = ssq_q + T; float* ssq_h1 = ssq_q + 2 * T; float* ssq_h2 = ssq_q + 3 * T; float* ssq_h3 = ssq_q + 4 * T; float* ssq_h4 = ssq_q + 5 * T; float* ssq_x = ssq_q + 6 * T;
    bf16* W_in = (bf16*)(ws + WS_WIN); bf16* W_uq = (bf16*)(ws + WS_WUQ); bf16* W_ukv = (bf16*)(ws + WS_WUKV); bf16* W_eo = (bf16*)(ws + WS_WEO);
    bf16* W_oqkv = (bf16*)(ws + WS_WOQKV); bf16* W_oo = (bf16*)(ws + WS_WOO);
    bf16* KR = (bf16*)(ws + WS_KR); bf16* XN = (bf16*)(ws + WS_XN); bf16* PROJ = (bf16*)(ws + WS_PROJ); bf16* QM = (bf16*)(ws + WS_QM); bf16* KVM = (bf16*)(ws + WS_KVM);
    bf16* MIX = (bf16*)(ws + WS_MIX); bf16* ACT = (bf16*)(ws + WS_ACT);
    float* HID = p.out;
    const int lo = p.ph_lo, hi = p.ph_hi;
    volatile LAS unsigned* bst = (volatile LAS unsigned*)(ldsl + 131072 + 64);
    if (tid < 2) bst[tid] = 0u;
    __syncthreads();
    XcdBarrier bar; bar.bar = (unsigned*)(ws + WS_CTL); bar.x = 0; bar.st = bst;
    if (hi - lo > 1) bar = xcd_barrier_post((unsigned*)(ws + WS_CTL), bst);
#ifndef PHMASK
#define PHMASK 0x3fff
#endif
#define IN(k) (((PHMASK >> (k)) & 1) && lo <= (k) && (k) < hi)
#ifndef DUPMASK
#define DUPMASK 0
#endif
#define REP(k) for (int rep_ = 0; rep_ < 1 + ((DUPMASK >> (k)) & 1); ++rep_)
#define SEAM(k) do { if (IN(k) && IN((k) + 1)) { if (p.coop_keep != 0) grid.sync();   xcd_barrier(bar); } } while (0)
#define GEMM_PHASE(EPI, E, Aptr, lda_, Bptr, ldb_, N_, K_) do { pg8::Gemm g{(const pg8::bf16_t*)(Aptr), (const pg8::bf16_t*)(Bptr), (lda_), (ldb_), T, (N_), (K_)}; \
        pg8::StaticOrder S; S.init(T, (N_), G, bx); pg8::gemm_phase<EPI, pg8::StaticOrder, true, true>(ldsl, g, S, E); } while (0)

    if (IN(0)) REP(0) {
        LAS float* scr = (LAS float*)(ldsl + wave * 16384);
        constexpr int I_IN = 16 * 59, I_UQ = 3 * 24, I_UKV = 2 * 32, I_SQ = 16 * 32, I_OQKV = 16 * 48, I_GU = 16 * 88, I_DN = 44 * 32;
        constexpr int NITEMS = I_IN + I_UQ + I_UKV + 2 * I_SQ + I_OQKV + 4 * I_GU + 2 * I_DN;
        for (int it = gw; it < NITEMS; it += NGW) {
            int r = it;
            if (r < I_IN) { transpose_item(p.in[2], 1024, 1888, W_in, 1024, 1, p.in[1], scr, r, lane); continue; } r -= I_IN;
            if (r < I_UQ) { transpose_item(p.in[4], 192, 768, W_uq, 256, 0, p.in[3], scr, r, lane); continue; } r -= I_UQ;
            if (r < I_UKV) { transpose_item(p.in[6], 128, 1024, W_ukv, 256, 0, p.in[5], scr, r, lane); continue; } r -= I_UKV;
            if (r < I_SQ) { transpose_item(p.in[12], 1024, 1024, W_eo, 1024, 0, nullptr, scr, r, lane); continue; } r -= I_SQ;
            if (r < I_SQ) { transpose_item(p.in[17], 1024, 1024, W_oo, 1024, 0, nullptr, scr, r, lane); continue; } r -= I_SQ;
            if (r < I_OQKV) { transpose_item(p.in[14], 1024, 1536, W_oqkv, 1024, 0, p.in[13], scr, r, lane); continue; } r -= I_OQKV;
            if (r < 4 * I_GU) { const int q = r / I_GU, l = q >> 1, up = q & 1; r -= q * I_GU;
                transpose_item(p.in[up ? 20 : 19] + (size_t)l * 1024 * FF, 1024, FF, (bf16*)(ws + (l ? WS_WGU1 : WS_WGU0)), 1024, up ? 3 : 2, p.in[18] + l * DM, scr, r, lane); continue; } r -= 4 * I_GU;
            { const int l = r / I_DN; r -= l * I_DN; transpose_item(p.in[21] + (size_t)l * FF * 1024, FF, 1024, (bf16*)(ws + (l ? WS_WDN1 : WS_WDN0)), FF, 0, nullptr, scr, r, lane); }
        }
        const int gt = bx * (NWAVES * 64) + tid, NGT = G * NWAVES * 64;
        for (int i = gt; i < (64 + 96) * 128; i += NGT) { const int rr = i >> 7, c8 = i & 127, row = rr < 64 ? 192 + rr : 416 + (rr - 64); *(v4u*)(W_in + (size_t)row * 1024 + c8 * 8) = (v4u){0u, 0u, 0u, 0u}; }
        for (int i = gt; i < 768 * 8; i += NGT) { const int row = i >> 3, c8 = i & 7; *(v4u*)(W_uq + (size_t)row * 256 + 192 + c8 * 8) = (v4u){0u, 0u, 0u, 0u}; }
        for (int i = gt; i < 1024 * 16; i += NGT) { const int row = i >> 4, c8 = i & 15; *(v4u*)(W_ukv + (size_t)row * 256 + 128 + c8 * 8) = (v4u){0u, 0u, 0u, 0u}; }
        for (int i = gt; i < 6 * T / 4; i += NGT) ((f32x4*)ssq_q)[i] = (f32x4){0.f, 0.f, 0.f, 0.f};
        for (int i = gt; i < 4096 * 16; i += NGT) { const int pos = i >> 4, f = i & 15; const float inv = exp2f(-(float)(2 * f) * (1.f / 32.f) * 18.931568569324174f); float s, c; sincosf((float)pos * inv, &s, &c); ((float*)tAc)[i] = c; ((float*)tAs)[i] = s; }
        for (int i = gt; i < 4096 * 8; i += NGT) { const int pos = i >> 3, f = i & 7; const float inv = exp2f(-(float)(2 * f) * (1.f / 16.f) * 18.931568569324174f); float s, c; sincosf((float)pos * inv, &s, &c); ((float*)tBc)[i] = c; ((float*)tBs)[i] = s; }
        for (int i = gt; i < 64 * 32; i += NGT) { const int pos = i >> 5, f = i & 31; const float inv = exp2f(-(float)(2 * f) * (1.f / 64.f) * 13.287712379549449f); float s, c; sincosf((float)pos * inv, &s, &c); ((float*)tCc)[i] = c; ((float*)tCs)[i] = s; }
        for (int m = gw; m < T; m += 4 * NGW) rows4_to_bf16_ssq(p.in[0], XN, ssq_x, m, NGW, lane);
        __syncthreads();
    }
    SEAM(0);
    if (IN(1)) REP(1) { pg8::EpiInProj E{PROJ, PROJ_LD, ssq_q, T, ssq_x, 1.f / DM}; GEMM_PHASE(pg8::EpiInProj, E, XN, DM, W_in, DM, PROJ_LD, DM); }
    SEAM(1);
    if (IN(2)) REP(2) {
        for (int m = gw; m < T; m += 4 * NGW) {
            float a1[4], a2[4], b1[4], b2[4], ca[4], sa[4], cb[4], sb[4];
            const int blk = lane >> 3, i = lane & 7, l16 = lane & 15;
#pragma unroll
            for (int t = 0; t < 4; ++t) { const int mm = m + t * NGW; const bf16* row = PROJ + (size_t)mm * PROJ_LD; const int pos = mm & (SEQ - 1);
                a1[t] = bf2f(row[384 + l16]); a2[t] = bf2f(row[384 + 16 + l16]); ca[t] = tAc[pos * 16 + l16]; sa[t] = tAs[pos * 16 + l16];
                b1[t] = bf2f(row[1024 + blk * 64 + i]); b2[t] = bf2f(row[1024 + blk * 64 + i + 8]); cb[t] = tBc[pos * 8 + i]; sb[t] = tBs[pos * 8 + i]; }
            asm volatile("" ::: "memory");
#pragma unroll
            for (int t = 0; t < 4; ++t) { const int mm = m + t * NGW; bf16* row = PROJ + (size_t)mm * PROJ_LD;
                if (lane < 16) { KR[(size_t)mm * 32 + lane] = (bf16)f2bf(a1[t] * ca[t] - a2[t] * sa[t]); KR[(size_t)mm * 32 + 16 + lane] = (bf16)f2bf(a2[t] * ca[t] + a1[t] * sa[t]); }
                bf16* kd = row + 1024 + blk * 64; kd[i] = (bf16)f2bf(b1[t] * cb[t] - b2[t] * sb[t]); kd[i + 8] = (bf16)f2bf(b2[t] * cb[t] + b1[t] * sb[t]); }
        }
        { pg8::EpiBf16S E{QM, 768, ssq_q, 1.f / 192.f}; GEMM_PHASE(pg8::EpiBf16S, E, PROJ, PROJ_LD, W_uq, 256, 768, 256); }
        { pg8::EpiBf16S E{KVM, 1024, ssq_kv, 1.f / 128.f}; GEMM_PHASE(pg8::EpiBf16S, E, PROJ + 256, PROJ_LD, W_ukv, 256, 1024, 256); }
    }
    SEAM(2);
    if (IN(3)) REP(3) {
        const int xcd = bx & 7, loc = bx >> 3;
#ifndef NO_MLA
        for (int i = 0; (i * G + bx) < 1024; ++i) {
            int u = i * G + bx, bh, qb;
            if (G == 256) { bh = i * 16 + xcd * 2 + (loc >> 4); qb = loc & 15; } else { bh = u >> 4; qb = u & 15; }
            const int b = bh >> 3, h = bh & 7; const size_t tok0 = (size_t)b * SEQ;
            att::AU a;
            a.Q = QM + (tok0 + qb * 256) * 768 + h * 96; a.ldq = 768;
            a.K0 = KVM + tok0 * 1024 + h * 128; a.ldk0 = 1024; a.K1 = KR + tok0 * 32; a.ldk1 = 32;
            a.V = KVM + tok0 * 1024 + h * 128 + 64; a.ldv = 1024; a.seq = SEQ; a.pos0 = qb * 256;
            a.C = 0.10206207261596575f * 1.4426950408889634f; a.thr = 8.f * 1.4426950408889634f; a.tc = tAc; a.ts = tAs; a.qg = nullptr;
            a.O = MIX + (tok0 + qb * 256) * 1024 + h * 64; a.ldo = 1024; a.scr = nullptr; a.lam = 0.f; a.osc = 1.f; a.subln = nullptr;
            att::attn_unit<96, 64, 8, 0, 0>(a, (char*)lds);
        }
#endif
#ifndef NO_DIFF
        float lam;
        { const float a1 = p.in[7][lane] * p.in[8][lane], a2 = p.in[9][lane] * p.in[10][lane]; lam = __expf(wave_sum(a1)) - __expf(wave_sum(a2)) + 0.2f; }
        for (int i = 0; (i * G + bx) < 512; ++i) {
            int u = i * G + bx, bh, qb;
            if (G == 256) { bh = i * 16 + xcd * 2 + (loc >> 4); qb = loc & 15; } else { bh = u >> 4; qb = u & 15; }
            const int b = bh >> 2, h = bh & 3; const size_t tok0 = (size_t)b * SEQ;
            att::AU a;
            a.ldq = PROJ_LD; a.ldk0 = PROJ_LD; a.K1 = nullptr; a.ldk1 = 0; a.V = PROJ + tok0 * PROJ_LD + 1536 + h * 128; a.ldv = PROJ_LD; a.seq = SEQ; a.pos0 = qb * 256;
            a.C = 0.125f * 1.4426950408889634f; a.thr = 8.f * 1.4426950408889634f; a.tc = tBc; a.ts = tBs; a.qg = nullptr;
            a.O = MIX + (tok0 + qb * 256) * 1024 + 512 + h * 128; a.ldo = 1024; a.scr = (float*)(ws + WS_SCR) + (size_t)bx * 32768; a.lam = lam; a.osc = 0.8f; a.subln = p.in[11];
            a.Q = PROJ + (tok0 + qb * 256) * PROJ_LD + 512 + h * 128 + 64; a.K0 = PROJ + tok0 * PROJ_LD + 1024 + h * 128 + 64;
#ifndef NO_D1
            att::attn_unit<64, 128, 8, 1, 1>(a, (char*)lds);
#endif
#ifndef NO_D2
            a.Q -= 64; a.K0 -= 64;
            att::attn_unit<64, 128, 8, 1, 2>(a, (char*)lds);
#endif
        }
#endif
    }
    SEAM(3);
    if (IN(4)) REP(4) { pg8::EpiResB<false> E{nullptr, XN, DM, ssq_h1}; GEMM_PHASE(pg8::EpiResB<false>, E, MIX, DM, W_eo, DM, DM, DM); }
    SEAM(4);
    if (IN(5)) REP(5) { pg8::EpiSwiGLU E{ACT, FF, ssq_h1, 1.f / DM}; GEMM_PHASE(pg8::EpiSwiGLU, E, XN, DM, ws + WS_WGU0, DM, 2 * FF, DM); }
    SEAM(5);
    if (IN(6)) REP(6) { pg8::EpiResB<false> E{nullptr, XN, DM, ssq_h2}; GEMM_PHASE(pg8::EpiResB<false>, E, ACT, FF, ws + WS_WDN0, FF, DM, FF); }
    SEAM(6);
    if (IN(7)) REP(7) { pg8::EpiBf16S E{PROJ, QKV_LD, ssq_h2, 1.f / DM}; GEMM_PHASE(pg8::EpiBf16S, E, XN, DM, W_oqkv, DM, QKV_LD, DM); }
    SEAM(7);
    if (IN(8)) REP(8) {
        const int hd = lane >> 5, li = lane & 31;
        const float g0 = p.in[16][li], g1 = p.in[16][li + 32], g2 = p.in[16][li + 64], g3 = p.in[16][li + 96];
        for (int m = gw; m < T; m += 4 * NGW) {
            float x0[4], x1[4], x2[4], x3[4];
#pragma unroll
            for (int t = 0; t < 4; ++t) { const bf16* kh = PROJ + (size_t)(m + t * NGW) * QKV_LD + 1024 + hd * 128; x0[t] = bf2f(kh[li]); x1[t] = bf2f(kh[li + 32]); x2[t] = bf2f(kh[li + 64]); x3[t] = bf2f(kh[li + 96]); }
            asm volatile("" ::: "memory");
#pragma unroll
            for (int t = 0; t < 4; ++t) { const int mm = m + t * NGW; bf16* kh = PROJ + (size_t)mm * QKV_LD + 1024 + hd * 128; const int pos = mm & (SEQ - 1), rowp = pos >> 6, colp = pos & 63;
                float ss = (x0[t] * x0[t] + x1[t] * x1[t]) + (x2[t] * x2[t] + x3[t] * x3[t]);
#pragma unroll
                for (int o = 1; o < 32; o <<= 1) ss += __shfl_xor(ss, o);
                const float rs = rsqrtf(ss * (1.f / 128.f) + EPS);
                const float y0 = x0[t] * rs * g0, y1 = x1[t] * rs * g1, y2 = x2[t] * rs * g2, y3 = x3[t] * rs * g3;
                const float cr = tCc[rowp * 32 + li], sr = tCs[rowp * 32 + li], cc = tCc[colp * 32 + li], sc = tCs[colp * 32 + li];
                kh[li] = (bf16)f2bf(y0 * cr - y1 * sr); kh[li + 32] = (bf16)f2bf(y1 * cr + y0 * sr); kh[li + 64] = (bf16)f2bf(y2 * cc - y3 * sc); kh[li + 96] = (bf16)f2bf(y3 * cc + y2 * sc); }
        }
    }
    SEAM(8);
    if (IN(9)) REP(9) {
        const int xcd = bx & 7, loc = bx >> 3;
        for (int i = 0; (i * G + bx) < 1024; ++i) {
            int u = i * G + bx, bh, qb;
            if (G == 256) { bh = i * 16 + xcd * 2 + (loc >> 4); qb = loc & 15; } else { bh = u >> 4; qb = u & 15; }
            const int b = bh >> 3, h = bh & 7, kvh = h >> 2; const size_t tok0 = (size_t)b * SEQ;
            att::AU a;
            a.Q = PROJ + (tok0 + qb * 256) * QKV_LD + h * 128; a.ldq = QKV_LD;
            a.K0 = PROJ + tok0 * QKV_LD + 1024 + kvh * 128; a.ldk0 = QKV_LD; a.K1 = nullptr; a.ldk1 = 0;
            a.V = PROJ + tok0 * QKV_LD + 1280 + kvh * 128; a.ldv = QKV_LD; a.seq = SEQ; a.pos0 = qb * 256;
            a.C = 0.08838834764831845f * 1.4426950408889634f; a.thr = 8.f * 1.4426950408889634f; a.tc = tCc; a.ts = tCs; a.qg = p.in[15];
            a.O = MIX + (tok0 + qb * 256) * 1024 + h * 128; a.ldo = 1024; a.scr = nullptr; a.lam = 0.f; a.osc = 1.f; a.subln = nullptr;
            att::attn_unit<128, 128, 16, 2, 0>(a, (char*)lds);
        }
    }
    SEAM(9);
    if (IN(10)) REP(10) { pg8::EpiResB<false> E{nullptr, XN, DM, ssq_h3}; GEMM_PHASE(pg8::EpiResB<false>, E, MIX, DM, W_oo, DM, DM, DM); }
    SEAM(10);
    if (IN(11)) REP(11) { pg8::EpiSwiGLU E{ACT, FF, ssq_h3, 1.f / DM}; GEMM_PHASE(pg8::EpiSwiGLU, E, XN, DM, ws + WS_WGU1, DM, 2 * FF, DM); }
    SEAM(11);
    if (IN(12)) REP(12) { pg8::EpiResB<false> E{nullptr, XN, DM, ssq_h4}; GEMM_PHASE(pg8::EpiResB<false>, E, ACT, FF, ws + WS_WDN1, FF, DM, FF); }
    SEAM(12);
    if (IN(13)) REP(13) {
        for (int m = gw; m < T; m += 4 * NGW) {
            v2u w[4][4]; float rs[4]; const f32x4* gr = (const f32x4*)p.in[22] + lane;
#pragma unroll
            for (int t = 0; t < 4; ++t) { const v2u* h = (const v2u*)(XN + (size_t)(m + t * NGW) * DM) + lane; rs[t] = ssq_h4[m + t * NGW];
#pragma unroll
                for (int j = 0; j < 4; ++j) w[t][j] = h[64 * j]; }
#pragma unroll
            for (int t = 0; t < 4; ++t) rs[t] = rsqrtf(rs[t] * (1.f / DM) + EPS);
#pragma unroll
            for (int j = 0; j < 4; ++j) { const f32x4 gg = gr[64 * j];
#pragma unroll
                for (int t = 0; t < 4; ++t) { f32x4* o = (f32x4*)(HID + (size_t)(m + t * NGW) * DM) + lane;
                    o[64 * j] = (f32x4){bf2f(w[t][j].x & 0xffffu), bf2f(w[t][j].x >> 16), bf2f(w[t][j].y & 0xffffu), bf2f(w[t][j].y >> 16)} * rs[t] * gg; } }
        }
    }
#undef IN
#undef SEAM
#undef GEMM_PHASE
}

#ifndef MK_PER_PHASE
#define MK_PER_PHASE 0
#endif
extern "C" void kernel_launch(void* const* d_in, const int* in_sizes, int n_in, void* d_out, int out_size, void* d_ws, size_t ws_size, hipStream_t stream) {
    static int grid = 0;
    if (grid == 0) {
        if (n_in != 23 || in_sizes[0] != T * DM || out_size != T * DM || ws_size < WS_END) { fprintf(stderr, "kernel_launch: shape mismatch (n_in %d in0 %d out %d ws %zu)\n", n_in, n_in > 0 ? in_sizes[0] : -1, out_size, ws_size); grid = -1; return; }
        int dev = 0, cus = 0, per_cu = 0;
        if (hipGetDevice(&dev) != hipSuccess || hipDeviceGetAttribute(&cus, hipDeviceAttributeMultiprocessorCount, dev) != hipSuccess) { grid = -1; return; }
        if (hipFuncSetAttribute((const void*)fwd_mega, hipFuncAttributeMaxDynamicSharedMemorySize, LDS_BYTES) != hipSuccess) { fprintf(stderr, "kernel_launch: hipFuncSetAttribute failed\n"); grid = -1; return; }
        if (hipOccupancyMaxActiveBlocksPerMultiprocessor(&per_cu, (const void*)fwd_mega, NWAVES * 64, LDS_BYTES) != hipSuccess || per_cu < 1) { fprintf(stderr, "kernel_launch: occupancy query says %d\n", per_cu); per_cu = 1; }
        (void)hipGetLastError();
        grid = cus;
    }
    if (grid < 0) return;
    if (hipMemsetAsync((char*)d_ws + WS_CTL, 0, CTL_ZERO_BYTES, stream) != hipSuccess) { fprintf(stderr, "kernel_launch: memset failed\n"); return; }
    Params p{};
    for (int i = 0; i < 23; ++i) p.in[i] = (const float*)d_in[i];
    p.out = (float*)d_out; p.ws = (unsigned char*)d_ws;
#if MK_PER_PHASE
    for (int k = 0; k < N_PHASES; ++k) { p.ph_lo = k; p.ph_hi = k + 1; hipLaunchKernelGGL(fwd_mega, dim3(grid), dim3(NWAVES * 64), LDS_BYTES, stream, p); }
#else
    p.ph_lo = 0; p.ph_hi = N_PHASES;
    void* args[] = {&p};
    hipError_t e = hipLaunchCooperativeKernel((const void*)fwd_mega, dim3(grid), dim3(NWAVES * 64), args, LDS_BYTES, stream);
    if (e != hipSuccess) fprintf(stderr, "kernel_launch: cooperative launch failed: %s (grid %d)\n", hipGetErrorString(e), grid);
#endif
}
```

```cpp
#include <hip/hip_runtime.h>
#include <hip/hip_cooperative_groups.h>
#include <cstdio>
#include <cstdint>
namespace cg = cooperative_groups;
namespace pg8 {
#define PG8_LAS __attribute__((address_space(3)))
typedef unsigned short bf16_t;
typedef short bf16x8 __attribute__((ext_vector_type(8)));
typedef float f32x4 __attribute__((ext_vector_type(4)));
typedef unsigned u32x4 __attribute__((ext_vector_type(4)));
constexpr int BM = 256, BK = 64, HALF = 128, HTB = HALF * BK * 2  , STAGE_BYTES = 8 * HTB, NXCD = 8, WGM = 4;

__host__ __device__ __forceinline__ int lds_byte(int r, int c) { const int st = (r >> 4) * 2 + (c >> 5), rr = r & 15, cc = c & 31, ob = rr * 64 + cc * 2; return st * 1024 + (ob ^ (((ob >> 9) & 1) << 5)); }
__host__ __device__ __forceinline__ void stage_rc(int b, int& R, int& C) { const int st = b / 1024, sb = b % 1024, swz = sb ^ (((sb >> 9) & 1) << 5); R = (st >> 1) * 16 + swz / 64; C = (st & 1) * 32 + (swz % 64) / 2; }
__host__ __device__ __forceinline__ int perm32(int rho) { const int n = rho >> 4, i = rho & 15; return 8 * (i >> 2) + 4 * n + (i & 3); }

struct Unit { int pm, pn; };
struct Gemm { const bf16_t* A; const bf16_t* Bt; int lda, ldb, M, N, K; };

struct StaticOrder {
    int nM, nN, nwg, G, c;
    __host__ __device__ void init(int M, int N, int G_, int c_) { nM = M / BM; nN = N / BM; nwg = nM * nN; G = G_; c = c_; }
    __host__ __device__ bool next(int i, Unit& u) const {
        const long L = (long)i * G + c; if (L >= nwg) return false;
        int wgid = (int)L; { const int q = nwg / NXCD, r = nwg % NXCD, xcd = wgid % NXCD, off = wgid / NXCD; wgid = (xcd < r ? xcd * (q + 1) : r * (q + 1) + (xcd - r) * q) + off; }
        const int nig = WGM * nN, gid = wgid / nig, fm = gid * WGM, gsz = (nM - fm) < WGM ? (nM - fm) : WGM;
        u.pm = fm + ((wgid % nig) % gsz); u.pn = (wgid % nig) / gsz; return true;
    }
    __device__ __forceinline__ void a_ready(const Unit&) const {}
    __device__ __forceinline__ void done(const Unit&) const {}
};

__device__ __forceinline__ unsigned cvt_pk_bf16(float lo, float hi) { unsigned r; asm volatile("v_cvt_pk_bf16_f32 %0, %1, %2" : "=v"(r) : "v"(lo), "v"(hi)); return r; }

struct EpiBf16S {
    static constexpr bool PERM = true, AFTER_DRAIN = false;
    bf16_t* O; int ldc; const float* ssq; float inv_n;
    __device__ __forceinline__ void operator()(const f32x4 (&acc)[2][2][4][2], const Unit& u, int wr, int wc, int fr, int fq) const {
        const int row0 = u.pm * BM + wr * 64 + fr, col0 = u.pn * BM + wc * 32 + 8 * fq;
        float sv[2][4];
#pragma unroll
        for (int ai = 0; ai < 2; ++ai)
#pragma unroll
            for (int m = 0; m < 4; ++m) sv[ai][m] = ssq ? ssq[row0 + ai * HALF + m * 16] : 0.f;
        asm volatile("" ::: "memory");
#pragma unroll
        for (int ai = 0; ai < 2; ++ai)
#pragma unroll
            for (int m = 0; m < 4; ++m) { const int row = row0 + ai * HALF + m * 16; const float s = ssq ? rsqrtf(sv[ai][m] * inv_n + 1e-6f) : 1.f; bf16_t* rowp = O + (size_t)row * ldc + col0;
#pragma unroll
                for (int bj = 0; bj < 2; ++bj) { const f32x4 v0 = acc[ai][bj][m][0] * s, v1 = acc[ai][bj][m][1] * s;
                    u32x4 w; w.x = cvt_pk_bf16(v0[0], v0[1]); w.y = cvt_pk_bf16(v0[2], v0[3]); w.z = cvt_pk_bf16(v1[0], v1[1]); w.w = cvt_pk_bf16(v1[2], v1[3]);
                    *(u32x4*)(rowp + bj * HALF) = w; } }
    }
};
struct EpiInProj {
    static constexpr bool PERM = true, AFTER_DRAIN = false;
    bf16_t* O; int ldc; float* ssq2; int sstride; const float* ssqx; float inv_n;
    __device__ __forceinline__ void operator()(const f32x4 (&acc)[2][2][4][2], const Unit& u, int wr, int wc, int fr, int fq) const {
        const int row0 = u.pm * BM + wr * 64 + fr, col0 = u.pn * BM + wc * 32 + 8 * fq;
        float sv[2][4];
#pragma unroll
        for (int ai = 0; ai < 2; ++ai)
#pragma unroll
            for (int m = 0; m < 4; ++m) sv[ai][m] = ssqx[row0 + ai * HALF + m * 16];
        asm volatile("" ::: "memory");
#pragma unroll
        for (int ai = 0; ai < 2; ++ai)
#pragma unroll
            for (int m = 0; m < 4; ++m) { const int row = row0 + ai * HALF + m * 16; bf16_t* rowp = O + (size_t)row * ldc + col0; const float sx = rsqrtf(sv[ai][m] * inv_n + 1e-6f);
#pragma unroll
                for (int bj = 0; bj < 2; ++bj) { const f32x4 v0 = acc[ai][bj][m][0] * sx, v1 = acc[ai][bj][m][1] * sx;
                    u32x4 w; w.x = cvt_pk_bf16(v0[0], v0[1]); w.y = cvt_pk_bf16(v0[2], v0[3]); w.z = cvt_pk_bf16(v1[0], v1[1]); w.w = cvt_pk_bf16(v1[2], v1[3]);
                    *(u32x4*)(rowp + bj * HALF) = w; }
                if (u.pn < 2) {
                    const f32x4 a0 = acc[ai][0][m][0] * sx, a1 = acc[ai][0][m][1] * sx; float s = (a0[0] * a0[0] + a0[1] * a0[1]) + (a0[2] * a0[2] + a0[3] * a0[3]) + (a1[0] * a1[0] + a1[1] * a1[1]) + (a1[2] * a1[2] + a1[3] * a1[3]);
                    if (u.pn == 0) { const f32x4 b0 = acc[ai][1][m][0] * sx, b1 = acc[ai][1][m][1] * sx; s += (b0[0] * b0[0] + b0[1] * b0[1]) + (b0[2] * b0[2] + b0[3] * b0[3]) + (b1[0] * b1[0] + b1[1] * b1[1]) + (b1[2] * b1[2] + b1[3] * b1[3]); }
                    s += __shfl_xor(s, 16); s += __shfl_xor(s, 32);
                    if (fq == 0) atomicAdd(ssq2 + (size_t)u.pn * sstride + row, s);
                } }
    }
};
__device__ __forceinline__ float silu_mul(float g, float u) { return g * u * __builtin_amdgcn_rcpf(1.f + __builtin_amdgcn_exp2f(-1.4426950408889634f * g)); }
struct EpiSwiGLU {
    static constexpr bool PERM = true, AFTER_DRAIN = false;
    bf16_t* O; int ldc; const float* ssq; float inv_n;
    __device__ __forceinline__ void operator()(const f32x4 (&acc)[2][2][4][2], const Unit& u, int wr, int wc, int fr, int fq) const {
        const int row0 = u.pm * BM + wr * 64 + fr, col0 = u.pn * HALF + wc * 32 + 8 * fq;
        float sv[2][4];
#pragma unroll
        for (int ai = 0; ai < 2; ++ai)
#pragma unroll
            for (int m = 0; m < 4; ++m) sv[ai][m] = ssq[row0 + ai * HALF + m * 16];
        asm volatile("" ::: "memory");
#pragma unroll
        for (int ai = 0; ai < 2; ++ai)
#pragma unroll
            for (int m = 0; m < 4; ++m) { const int row = row0 + ai * HALF + m * 16; bf16_t* rowp = O + (size_t)row * ldc + col0; const float s = rsqrtf(sv[ai][m] * inv_n + 1e-6f);
                const f32x4 g0 = acc[ai][0][m][0] * s, g1 = acc[ai][0][m][1] * s, u0 = acc[ai][1][m][0] * s, u1 = acc[ai][1][m][1] * s;
                u32x4 w; w.x = cvt_pk_bf16(silu_mul(g0[0], u0[0]), silu_mul(g0[1], u0[1])); w.y = cvt_pk_bf16(silu_mul(g0[2], u0[2]), silu_mul(g0[3], u0[3]));
                w.z = cvt_pk_bf16(silu_mul(g1[0], u1[0]), silu_mul(g1[1], u1[1])); w.w = cvt_pk_bf16(silu_mul(g1[2], u1[2]), silu_mul(g1[3], u1[3]));
                *(u32x4*)rowp = w; }
    }
};
struct EpiResF32N {
    static constexpr bool PERM = false, AFTER_DRAIN = false;
    const float* res; float* out; int ldc; bf16_t* hb; float* ssq;
    __device__ __forceinline__ void operator()(const f32x4 (&acc)[2][2][4][2], const Unit& u, int wr, int wc, int fr, int fq) const {
        const int row0 = u.pm * BM + wr * 64 + fr, col0 = u.pn * BM + wc * 32 + 4 * fq;
        typedef unsigned u32x2 __attribute__((ext_vector_type(2)));
#pragma unroll
        for (int ai = 0; ai < 2; ++ai)
#pragma unroll
            for (int mp = 0; mp < 1; ++mp) { f32x4 r[4][2][2];
#pragma unroll
                for (int mm = 0; mm < 4; ++mm) { const size_t off = (size_t)(row0 + ai * HALF + mm * 16) * ldc + col0;
#pragma unroll
                    for (int bj = 0; bj < 2; ++bj)
#pragma unroll
                        for (int n = 0; n < 2; ++n) r[mm][bj][n] = *(const f32x4*)(res + off + bj * HALF + n * 16); }
                asm volatile("" ::: "memory");
#pragma unroll
                for (int mm = 0; mm < 4; ++mm) { const int m = mm, row = row0 + ai * HALF + m * 16; const size_t off = (size_t)row * ldc + col0; float s = 0.f;
#pragma unroll
                    for (int bj = 0; bj < 2; ++bj)
#pragma unroll
                        for (int n = 0; n < 2; ++n) { const f32x4 v = r[mm][bj][n] + acc[ai][bj][m][n]; *(f32x4*)(out + off + bj * HALF + n * 16) = v;
                            s += (v[0] * v[0] + v[1] * v[1]) + (v[2] * v[2] + v[3] * v[3]);
                            u32x2 w; w.x = cvt_pk_bf16(v[0], v[1]); w.y = cvt_pk_bf16(v[2], v[3]); *(u32x2*)(hb + off + bj * HALF + n * 16) = w; }
                    s += __shfl_xor(s, 16); s += __shfl_xor(s, 32);
                    if (fq == 0) atomicAdd(ssq + row, s); } }
    }
};
template <bool RF32> struct EpiResB {
    static constexpr bool PERM = true, AFTER_DRAIN = false;
    const float* resf; bf16_t* hb; int ldc; float* ssq;
    __device__ __forceinline__ void operator()(const f32x4 (&acc)[2][2][4][2], const Unit& u, int wr, int wc, int fr, int fq) const {
        const int row0 = u.pm * BM + wr * 64 + fr, col0 = u.pn * BM + wc * 32 + 8 * fq;
#pragma unroll
        for (int ai = 0; ai < 2; ++ai) { f32x4 r[4][2][2];
#pragma unroll
            for (int m = 0; m < 4; ++m) { const size_t off = (size_t)(row0 + ai * HALF + m * 16) * ldc + col0;
#pragma unroll
                for (int bj = 0; bj < 2; ++bj) {
                    if constexpr (RF32) { r[m][bj][0] = *(const f32x4*)(resf + off + bj * HALF); r[m][bj][1] = *(const f32x4*)(resf + off + bj * HALF + 4); }
                    else { const u32x4 w = *(const u32x4*)(hb + off + bj * HALF);
                        r[m][bj][0] = (f32x4){__uint_as_float(w.x << 16), __uint_as_float(w.x & 0xffff0000u), __uint_as_float(w.y << 16), __uint_as_float(w.y & 0xffff0000u)};
                        r[m][bj][1] = (f32x4){__uint_as_float(w.z << 16), __uint_as_float(w.z & 0xffff0000u), __uint_as_float(w.w << 16), __uint_as_float(w.w & 0xffff0000u)}; } } }
            asm volatile("" ::: "memory");
#pragma unroll
            for (int m = 0; m < 4; ++m) { const int row = row0 + ai * HALF + m * 16; const size_t off = (size_t)row * ldc + col0; float s = 0.f;
#pragma unroll
                for (int bj = 0; bj < 2; ++bj) { const f32x4 v0 = r[m][bj][0] + acc[ai][bj][m][0], v1 = r[m][bj][1] + acc[ai][bj][m][1];
                    s += (v0[0] * v0[0] + v0[1] * v0[1]) + (v0[2] * v0[2] + v0[3] * v0[3]) + (v1[0] * v1[0] + v1[1] * v1[1]) + (v1[2] * v1[2] + v1[3] * v1[3]);
                    u32x4 w; w.x = cvt_pk_bf16(v0[0], v0[1]); w.y = cvt_pk_bf16(v0[2], v0[3]); w.z = cvt_pk_bf16(v1[0], v1[1]); w.w = cvt_pk_bf16(v1[2], v1[3]);
                    *(u32x4*)(hb + off + bj * HALF) = w; }
                s += __shfl_xor(s, 16); s += __shfl_xor(s, 32);
                if (fq == 0) atomicAdd(ssq + row, s); } }
    }
};
struct EpiResF32 {
    static constexpr bool PERM = false, AFTER_DRAIN = false;
    const float* res; float* out; int ldc;
    __device__ __forceinline__ void operator()(const f32x4 (&acc)[2][2][4][2], const Unit& u, int wr, int wc, int fr, int fq) const {
        const int row0 = u.pm * BM + wr * 64 + fr, col0 = u.pn * BM + wc * 32 + 4 * fq;
#pragma unroll
        for (int ai = 0; ai < 2; ++ai)
#pragma unroll
            for (int mp = 0; mp < 1; ++mp) { f32x4 r[4][2][2];
#pragma unroll
                for (int mm = 0; mm < 4; ++mm) { const size_t off = (size_t)(row0 + ai * HALF + mm * 16) * ldc + col0;
#pragma unroll
                    for (int bj = 0; bj < 2; ++bj)
#pragma unroll
                        for (int n = 0; n < 2; ++n) r[mm][bj][n] = *(const f32x4*)(res + off + bj * HALF + n * 16); }
                asm volatile("" ::: "memory");
#pragma unroll
                for (int mm = 0; mm < 4; ++mm) { const int m = mm; const size_t off = (size_t)(row0 + ai * HALF + m * 16) * ldc + col0;
#pragma unroll
                    for (int bj = 0; bj < 2; ++bj)
#pragma unroll
                        for (int n = 0; n < 2; ++n) *(f32x4*)(out + off + bj * HALF + n * 16) = r[mm][bj][n] + acc[ai][bj][m][n]; } }
    }
};


template <class Epi, class Sched, bool ALIGN_EPI = false, bool SP2 = false>
__device__ __forceinline__ void gemm_phase(PG8_LAS unsigned char* lds, const Gemm g, const Sched& S, const Epi& E) {
    const int tid = threadIdx.x, wid = __builtin_amdgcn_readfirstlane(tid >> 6), lane = tid & 63, wr = wid >> 2, wc = wid & 3, fr = lane & 15, fq = lane >> 4;
    const int K = g.K, nt = K / BK;
    unsigned voffA[2], voffB[2];
#pragma unroll
    for (int i = 0; i < 2; ++i) { int R, C; stage_rc(tid * 16 + i * 8192, R, C); const int Rb = Epi::PERM ? ((R & ~31) + perm32(R & 31)) : R;
        voffA[i] = (unsigned)(R * g.lda + C) * 2u; voffB[i] = (unsigned)(Rb * g.ldb + C) * 2u; }
    const size_t kstep = (size_t)(BK * 2);
    const size_t hstepA = (size_t)HALF * g.lda * 2, hstepB = (size_t)HALF * g.ldb * 2;
    const size_t tstepA = 2 * hstepA, tstepB = 2 * hstepB;
    const unsigned ldsw = (unsigned)wid * 1024u;
    const int aoff = lds_byte(wr * 64 + fr, fq * 8), boff = lds_byte(wc * 32 + fr, fq * 8);
#define PG8_SA(b, h) (((b) * 2 + (h)) * HTB)
#define PG8_SB(b, h) ((4 + (b) * 2 + (h)) * HTB)
#define PG8_STAGE(bufoff, gbase, voff) do { _Pragma("unroll") for (int _i = 0; _i < 2; ++_i) \
        __builtin_amdgcn_global_load_lds((const unsigned*)((const char*)(gbase) + (voff)[_i]), (PG8_LAS unsigned*)(lds + (bufoff) + ldsw + _i * 8192), 16, 0, 0); } while (0)
#define PG8_LDA(dst, b, h) do { _Pragma("unroll") for (int m = 0; m < 4; ++m) _Pragma("unroll") for (int k = 0; k < 2; ++k) dst[m][k] = *(const PG8_LAS bf16x8*)(lds + PG8_SA(b, h) + aoff + m * 2048 + k * 1024); } while (0)
#define PG8_LDB(dst, b, h) do { _Pragma("unroll") for (int n = 0; n < 2; ++n) _Pragma("unroll") for (int k = 0; k < 2; ++k) dst[n][k] = *(const PG8_LAS bf16x8*)(lds + PG8_SB(b, h) + boff + n * 2048 + k * 1024); } while (0)
#define PG8_MMA(ai, bj, At, Bt) do { __builtin_amdgcn_s_setprio(1); _Pragma("unroll") for (int m = 0; m < 4; ++m) _Pragma("unroll") for (int n = 0; n < 2; ++n) _Pragma("unroll") for (int k = 0; k < 2; ++k) \
        acc[ai][bj][m][n] = __builtin_amdgcn_mfma_f32_16x16x32_bf16(Bt[n][k], At[m][k], acc[ai][bj][m][n], 0, 0, 0); __builtin_amdgcn_s_setprio(0); } while (0)
#define PG8_WAIT_V(n) asm volatile("s_waitcnt vmcnt(" #n ")" ::: "memory")
#define PG8_WAIT_L(n) asm volatile("s_waitcnt lgkmcnt(" #n ")" ::: "memory")
#define PG8_BAR __builtin_amdgcn_s_barrier()
#define PG8_SCHED __builtin_amdgcn_sched_barrier(0)
    Unit cur, nxt; int ui = 0;
    if (!S.next(0, cur)) return;
    f32x4 acc[2][2][4][2];
#pragma unroll
    for (int a = 0; a < 2; ++a)
#pragma unroll
        for (int b = 0; b < 2; ++b)
#pragma unroll
            for (int m = 0; m < 4; ++m)
#pragma unroll
                for (int n = 0; n < 2; ++n) acc[a][b][m][n] = (f32x4){0.f, 0.f, 0.f, 0.f};
    bf16x8 At[4][2], B0[2][2], B1[2][2];
    const char* cA = (const char*)g.A + (size_t)cur.pm * tstepA; const char* cB = (const char*)g.Bt + (size_t)cur.pn * tstepB;
    S.a_ready(cur);
    if constexpr (SP2) {
        PG8_STAGE(PG8_SB(0, 0), cB, voffB); PG8_STAGE(PG8_SB(0, 1), cB + hstepB, voffB); PG8_STAGE(PG8_SA(0, 0), cA, voffA); PG8_STAGE(PG8_SA(0, 1), cA + hstepA, voffA);
        if (wr == 1) PG8_BAR;
        PG8_WAIT_V(2); PG8_BAR;
        PG8_STAGE(PG8_SB(1, 0), cB + kstep, voffB); PG8_STAGE(PG8_SA(1, 0), cA + kstep, voffA); PG8_STAGE(PG8_SB(1, 1), cB + hstepB + kstep, voffB);
        PG8_WAIT_V(6); PG8_BAR;
    } else {
        PG8_STAGE(PG8_SB(0, 0), cB, voffB); PG8_STAGE(PG8_SA(0, 0), cA, voffA); PG8_STAGE(PG8_SB(0, 1), cB + hstepB, voffB); PG8_STAGE(PG8_SA(0, 1), cA + hstepA, voffA);
        if (wr == 1) PG8_BAR;
        PG8_WAIT_V(4); PG8_BAR;
        PG8_STAGE(PG8_SB(1, 0), cB + kstep, voffB); PG8_STAGE(PG8_SA(1, 0), cA + kstep, voffA); PG8_STAGE(PG8_SB(1, 1), cB + hstepB + kstep, voffB);
        PG8_WAIT_V(6); PG8_BAR;
    }
    for (;;) {
        const bool has_next = S.next(ui + 1, nxt);
        const char* nA = has_next ? (const char*)g.A + (size_t)nxt.pm * tstepA : cA; const char* nB = has_next ? (const char*)g.Bt + (size_t)nxt.pn * tstepB : cB;
        for (int t = 0; t < nt; t += 2) {
            const bool last = (t == nt - 2);
            const char* a1 = cA + (size_t)(t + 1) * kstep;
            const char* a2 = last ? nA : cA + (size_t)(t + 2) * kstep; const char* b2 = last ? nB : cB + (size_t)(t + 2) * kstep;
            const char* a3 = a2 + kstep; const char* b3 = b2 + kstep;
            if (last && has_next) S.a_ready(nxt);
            if constexpr (SP2) {
            PG8_LDB(B0, 0, 0); PG8_LDB(B1, 0, 1); PG8_SCHED; PG8_LDA(At, 0, 0); PG8_STAGE(PG8_SA(1, 1), a1 + hstepA, voffA);
            PG8_WAIT_V(8); PG8_WAIT_L(0); PG8_BAR; PG8_MMA(0, 0, At, B0); PG8_MMA(0, 1, At, B1); PG8_BAR; PG8_SCHED;
            PG8_LDA(At, 0, 1); PG8_STAGE(PG8_SB(0, 0), b2, voffB); PG8_STAGE(PG8_SB(0, 1), b2 + hstepB, voffB); PG8_STAGE(PG8_SA(0, 0), a2, voffA);
            PG8_WAIT_V(8); PG8_WAIT_L(0); PG8_BAR; PG8_MMA(1, 0, At, B0); PG8_MMA(1, 1, At, B1); PG8_BAR; PG8_SCHED;
            PG8_LDB(B0, 1, 0); PG8_LDB(B1, 1, 1); PG8_SCHED; PG8_LDA(At, 1, 0); PG8_STAGE(PG8_SA(0, 1), a2 + hstepA, voffA);
            PG8_WAIT_V(8); PG8_WAIT_L(0); PG8_BAR; PG8_MMA(0, 0, At, B0); PG8_MMA(0, 1, At, B1); PG8_BAR; PG8_SCHED;
            PG8_LDA(At, 1, 1); PG8_STAGE(PG8_SB(1, 0), b3, voffB); PG8_STAGE(PG8_SB(1, 1), b3 + hstepB, voffB); PG8_STAGE(PG8_SA(1, 0), a3, voffA);
            PG8_WAIT_V(8); PG8_WAIT_L(0); PG8_BAR; PG8_MMA(1, 0, At, B0); PG8_MMA(1, 1, At, B1); PG8_BAR; PG8_SCHED;
            } else {
            PG8_LDB(B0, 0, 0); PG8_SCHED; PG8_LDA(At, 0, 0); PG8_STAGE(PG8_SA(1, 1), a1 + hstepA, voffA);
            PG8_WAIT_L(8); PG8_BAR; PG8_WAIT_L(0); PG8_MMA(0, 0, At, B0); PG8_BAR; PG8_SCHED;
            PG8_LDB(B1, 0, 1); PG8_STAGE(PG8_SB(0, 0), b2, voffB);
            PG8_BAR; PG8_WAIT_L(0); PG8_MMA(0, 1, At, B1); PG8_BAR;
            PG8_LDA(At, 0, 1); PG8_STAGE(PG8_SA(0, 0), a2, voffA);
            PG8_BAR; PG8_WAIT_L(0); PG8_MMA(1, 0, At, B0); PG8_BAR; PG8_SCHED;
            PG8_STAGE(PG8_SB(0, 1), b2 + hstepB, voffB);
            PG8_WAIT_V(6); PG8_BAR; PG8_MMA(1, 1, At, B1); PG8_BAR;
            PG8_LDB(B0, 1, 0); PG8_SCHED; PG8_LDA(At, 1, 0); PG8_STAGE(PG8_SA(0, 1), a2 + hstepA, voffA);
            PG8_WAIT_L(8); PG8_BAR; PG8_WAIT_L(0); PG8_MMA(0, 0, At, B0); PG8_BAR; PG8_SCHED;
            PG8_LDB(B1, 1, 1); PG8_STAGE(PG8_SB(1, 0), b3, voffB);
            PG8_BAR; PG8_WAIT_L(0); PG8_MMA(0, 1, At, B1); PG8_BAR;
            PG8_LDA(At, 1, 1); PG8_STAGE(PG8_SA(1, 0), a3, voffA);
            PG8_BAR; PG8_WAIT_L(0); PG8_MMA(1, 0, At, B0); PG8_BAR; PG8_SCHED;
            PG8_STAGE(PG8_SB(1, 1), b3 + hstepB, voffB);
            PG8_WAIT_V(6); PG8_BAR; PG8_MMA(1, 1, At, B1); PG8_BAR;
            }
        }
        if constexpr (ALIGN_EPI) { if (wr == 0) PG8_BAR; }
        if constexpr (!Epi::AFTER_DRAIN) { E(acc, cur, wr, wc, fr, fq); S.done(cur); }
        if (!has_next) break;
#pragma unroll
        for (int a = 0; a < 2; ++a)
#pragma unroll
            for (int b = 0; b < 2; ++b)
#pragma unroll
                for (int m = 0; m < 4; ++m)
#pragma unroll
                    for (int n = 0; n < 2; ++n) acc[a][b][m][n] = (f32x4){0.f, 0.f, 0.f, 0.f};
        cur = nxt; cA = nA; cB = nB; ++ui;
        if constexpr (ALIGN_EPI) { if (wr == 1) PG8_BAR; }
    }
    PG8_WAIT_V(0);
    if constexpr (!ALIGN_EPI) { if (wr == 0) PG8_BAR; }
    PG8_BAR;
    if constexpr (Epi::AFTER_DRAIN) { E.fused(acc, cur, wr, wc, fr, fq, lds, wid, lane); S.done(cur); }
#undef PG8_SA
#undef PG8_SB
#undef PG8_STAGE
#undef PG8_LDA
#undef PG8_LDB
#undef PG8_MMA
#undef PG8_WAIT_V
#undef PG8_WAIT_L
#undef PG8_BAR
#undef PG8_SCHED
}
}
namespace att {
typedef unsigned short bf16;
typedef short bf16x8 __attribute__((ext_vector_type(8)));
typedef short s16x4 __attribute__((ext_vector_type(4)));
typedef float f32x16 __attribute__((ext_vector_type(16)));
typedef float f32x4 __attribute__((ext_vector_type(4)));
typedef unsigned u32x4 __attribute__((ext_vector_type(4)));
constexpr int NW = 8, QBLK = 32, KVBLK = 64;
constexpr int KROW = 272  , SHM_V = 16384, SHM_K = 64 * KROW, SLOTB = SHM_V + SHM_K, LDS_WS = 3 * SLOTB, LDS_BYTES = LDS_WS + NW * 64 * 4;
#define KSWZ(row, colB) ((row) * 256 + ((colB) ^ (((row) & 15) << 4)))
#define SBAR() __builtin_amdgcn_sched_barrier(0)
__device__ __forceinline__ int crow(int r, int hi) { return (r & 3) + 8 * (r >> 2) + 4 * hi; }
__device__ __forceinline__ unsigned cvtpk(float lo, float hi) { unsigned r; asm volatile("v_cvt_pk_bf16_f32 %0, %1, %2" : "=v"(r) : "v"(lo), "v"(hi)); return r; }
__device__ __forceinline__ float bf2f(short b) { return __uint_as_float(((unsigned)(unsigned short)b) << 16); }
__device__ __forceinline__ bf16x8 ld8(const bf16* p) { return *reinterpret_cast<const bf16x8*>(p); }
__device__ __forceinline__ bf16x8 pack8(const float* x) { u32x4 w = {cvtpk(x[0], x[1]), cvtpk(x[2], x[3]), cvtpk(x[4], x[5]), cvtpk(x[6], x[7])}; return *reinterpret_cast<bf16x8*>(&w); }

__device__ __forceinline__ void partialSM(f32x16& p0, f32x16& p1, float& m_reg, float& mn, float& alpha, const float C, const float thr) {
  float pmax = p0[0];
#pragma unroll
  for (int r = 1; r < 16; ++r) pmax = fmaxf(pmax, p0[r]);
#pragma unroll
  for (int r = 0; r < 16; ++r) pmax = fmaxf(pmax, p1[r]);
  { auto rr = __builtin_amdgcn_permlane32_swap(__float_as_uint(pmax), __float_as_uint(pmax), false, false);
    pmax = fmaxf(__uint_as_float(rr[0]), __uint_as_float(rr[1])); }
  if (__builtin_expect(__all(pmax - m_reg <= thr), 1)) { mn = m_reg; alpha = 1.f; }
  else { mn = fmaxf(m_reg, pmax); alpha = __builtin_amdgcn_exp2f((m_reg - mn) * C); m_reg = mn; }
  float mnC = -mn * C;
#pragma unroll
  for (int r = 0; r < 16; ++r) p0[r] = fmaf(p0[r], C, mnC);
#pragma unroll
  for (int r = 0; r < 16; ++r) p1[r] = fmaf(p1[r], C, mnC);
#pragma unroll
  for (int r = 0; r < 16; ++r) p0[r] = __builtin_amdgcn_exp2f(p0[r]);
}
__device__ __forceinline__ void finishSM(f32x16& p0, f32x16& p1, float alpha, float& l_reg, bf16x8& pa0, bf16x8& pa1, bf16x8& pa2, bf16x8& pa3) {
#pragma unroll
  for (int r = 0; r < 16; ++r) p1[r] = __builtin_amdgcn_exp2f(p1[r]);
  float ps = 0;
#pragma unroll
  for (int r = 0; r < 16; ++r) ps += p0[r];
#pragma unroll
  for (int r = 0; r < 16; ++r) ps += p1[r];
  { auto rr = __builtin_amdgcn_permlane32_swap(__float_as_uint(ps), __float_as_uint(ps), false, false);
    ps = __uint_as_float(rr[0]) + __uint_as_float(rr[1]); }
  l_reg = l_reg * alpha + ps;
#define PK4(P, BASE, OUT) do { unsigned a0 = cvtpk(P[BASE + 0], P[BASE + 1]), a1 = cvtpk(P[BASE + 2], P[BASE + 3]);   \
    unsigned b0 = cvtpk(P[BASE + 4], P[BASE + 5]), b1 = cvtpk(P[BASE + 6], P[BASE + 7]);                              \
    auto r0 = __builtin_amdgcn_permlane32_swap(a0, b0, false, false); auto r1 = __builtin_amdgcn_permlane32_swap(a1, b1, false, false); \
    u32x4 w = {r0[0], r1[0], r0[1], r1[1]}; OUT = *reinterpret_cast<bf16x8*>(&w); } while (0)
  PK4(p0, 0, pa0); PK4(p0, 8, pa1); PK4(p1, 0, pa2); PK4(p1, 8, pa3);
#undef PK4
}
template <int NQ>
__device__ __forceinline__ void qkt(f32x16& p0, f32x16& p1, const char* Ks, const bf16x8* qr, int r32, int hi) {
  p0 = f32x16{}; p1 = f32x16{};
#pragma unroll
  for (int d0 = 0; d0 < NQ; ++d0) { int cb = (d0 * 16 + hi * 8) * 2;
    bf16x8 b0 = *reinterpret_cast<const bf16x8*>(Ks + KSWZ(r32, cb));
    bf16x8 b1 = *reinterpret_cast<const bf16x8*>(Ks + KSWZ(32 + r32, cb));
    p0 = __builtin_amdgcn_mfma_f32_32x32x16_bf16(b0, qr[d0], p0, 0, 0, 0);
    p1 = __builtin_amdgcn_mfma_f32_32x32x16_bf16(b1, qr[d0], p1, 0, 0, 0); }
}
template <int NSUB> __device__ __forceinline__ int v_st(int k, int c) { const int kk = (k & ~0xC) | ((k & 4) << 1) | ((k & 8) >> 1); return ((kk >> 3) * NSUB + (c >> 5)) * 512 + ((kk & 7) * 32 + (c & 31)) * 2; }
__device__ __forceinline__ int v_rd_base(int lane) { return ((lane & 3) << 3) | (((lane >> 2) & 3) << 6) | (((lane >> 4) & 1) << 5) | (((lane >> 5) & 1) << 8); }
template <int NSUB> constexpr int v_rd_off(int d0, int ks, int half) { return ((2 * ks + half) * NSUB + d0) * 512; }
template <int OFF> __device__ __forceinline__ s16x4 tr_read(int vb) {
  s16x4 r; asm volatile("ds_read_b64_tr_b16 %0, %1 offset:%2" : "=&v"(r) : "v"(vb), "i"(OFF) : "memory"); return r;
}
template <int NSUB, int D0> __device__ __forceinline__ void pv_one(f32x16& od, int vb, bf16x8 pa0, bf16x8 pa1, bf16x8 pa2, bf16x8 pa3) {
  const s16x4 l0 = tr_read<v_rd_off<NSUB>(D0, 0, 0)>(vb), h0 = tr_read<v_rd_off<NSUB>(D0, 0, 1)>(vb), l1 = tr_read<v_rd_off<NSUB>(D0, 1, 0)>(vb), h1 = tr_read<v_rd_off<NSUB>(D0, 1, 1)>(vb);
  const s16x4 l2 = tr_read<v_rd_off<NSUB>(D0, 2, 0)>(vb), h2 = tr_read<v_rd_off<NSUB>(D0, 2, 1)>(vb), l3 = tr_read<v_rd_off<NSUB>(D0, 3, 0)>(vb), h3 = tr_read<v_rd_off<NSUB>(D0, 3, 1)>(vb);
  asm volatile("s_waitcnt lgkmcnt(0)" ::: "memory"); SBAR();
#define PK(L, H) (bf16x8){L[0], L[1], L[2], L[3], H[0], H[1], H[2], H[3]}
  od = __builtin_amdgcn_mfma_f32_32x32x16_bf16(pa0, PK(l0, h0), od, 0, 0, 0);
  od = __builtin_amdgcn_mfma_f32_32x32x16_bf16(pa1, PK(l1, h1), od, 0, 0, 0);
  od = __builtin_amdgcn_mfma_f32_32x32x16_bf16(pa2, PK(l2, h2), od, 0, 0, 0);
  od = __builtin_amdgcn_mfma_f32_32x32x16_bf16(pa3, PK(l3, h3), od, 0, 0, 0);
#undef PK
}
template <int NSUB> __device__ __forceinline__ void pv_d0(f32x16* o, int vb, bf16x8 pa0, bf16x8 pa1, bf16x8 pa2, bf16x8 pa3) {
  pv_one<NSUB, 0>(o[0], vb, pa0, pa1, pa2, pa3); pv_one<NSUB, 1>(o[1], vb, pa0, pa1, pa2, pa3);
  if constexpr (NSUB == 4) { pv_one<NSUB, 2>(o[2], vb, pa0, pa1, pa2, pa3); pv_one<NSUB, 3>(o[3], vb, pa0, pa1, pa2, pa3); }
}


#define PK4(P, BASE, OUT) do { unsigned a0 = cvtpk(P[BASE + 0], P[BASE + 1]), a1 = cvtpk(P[BASE + 2], P[BASE + 3]);   \
    unsigned b0 = cvtpk(P[BASE + 4], P[BASE + 5]), b1 = cvtpk(P[BASE + 6], P[BASE + 7]);                              \
    auto r0 = __builtin_amdgcn_permlane32_swap(a0, b0, false, false); auto r1 = __builtin_amdgcn_permlane32_swap(a1, b1, false, false); \
    u32x4 w = {r0[0], r1[0], r0[1], r1[1]}; OUT = *reinterpret_cast<bf16x8*>(&w); } while (0)
struct FinSt { float ps0, ps1; bf16x8 pa0, pa1, pa2, pa3; };
template <int CH> __device__ __forceinline__ void fin_chunk(f32x16& y0, f32x16& y1, FinSt& f) {
  if constexpr (CH < 4) {
#pragma unroll
    for (int j = 0; j < 4; ++j) y1[4 * CH + j] = __builtin_amdgcn_exp2f(y1[4 * CH + j]);
    f.ps0 += y0[4 * CH] + y0[4 * CH + 1]; f.ps1 += y0[4 * CH + 2] + y0[4 * CH + 3];
    if constexpr (CH == 0) PK4(y0, 0, f.pa0);
    if constexpr (CH == 1) PK4(y0, 8, f.pa1);
  } else {
    constexpr int c = CH - 4;
    f.ps0 += y1[4 * c] + y1[4 * c + 1]; f.ps1 += y1[4 * c + 2] + y1[4 * c + 3];
    if constexpr (CH == 4) PK4(y1, 0, f.pa2);
    if constexpr (CH == 6) PK4(y1, 8, f.pa3);
  }
}
template <int LO, int HI> __device__ __forceinline__ void fin_range(f32x16& y0, f32x16& y1, FinSt& f) {
  if constexpr (LO < HI) { fin_chunk<LO>(y0, y1, f); fin_range<LO + 1, HI>(y0, y1, f); }
}
template <int D0, int NQ, bool FIN>
__device__ __forceinline__ void qk_steps(f32x16& x0, f32x16& x1, bf16x8 kc0, bf16x8 kc1, const char* Ks, const bf16x8* qr, int r32, int hi, f32x16& y0, f32x16& y1, FinSt& f, const f32x16& cneg) {
  if constexpr (D0 < NQ) {
    bf16x8 kn0 = kc0, kn1 = kc1;
    if constexpr (D0 + 1 < NQ) { kn0 = *reinterpret_cast<const bf16x8*>(Ks + (D0 + 1) * 32); kn1 = *reinterpret_cast<const bf16x8*>(Ks + (D0 + 1) * 32 + 32 * KROW); }
    if constexpr (D0 == 0) { x0 = __builtin_amdgcn_mfma_f32_32x32x16_bf16(kc0, qr[0], cneg, 0, 0, 0); x1 = __builtin_amdgcn_mfma_f32_32x32x16_bf16(kc1, qr[0], cneg, 0, 0, 0); }
    else { x0 = __builtin_amdgcn_mfma_f32_32x32x16_bf16(kc0, qr[D0], x0, 0, 0, 0); x1 = __builtin_amdgcn_mfma_f32_32x32x16_bf16(kc1, qr[D0], x1, 0, 0, 0); }
    if constexpr (FIN) {
      fin_range<(D0 * 8) / NQ, ((D0 + 1) * 8) / NQ>(y0, y1, f);
      constexpr int NV = 6 * (((D0 + 1) * 8) / NQ - (D0 * 8) / NQ);
      __builtin_amdgcn_sched_group_barrier(0x008, 1, 0); __builtin_amdgcn_sched_group_barrier(0x002, NV, 0);
      __builtin_amdgcn_sched_group_barrier(0x008, 1, 0); __builtin_amdgcn_sched_group_barrier(0x002, 2 * NV, 0);
    }
    SBAR();
    qk_steps<D0 + 1, NQ, FIN>(x0, x1, kn0, kn1, Ks, qr, r32, hi, y0, y1, f, cneg);
  }
}
template <int NQ, bool FIN>
__device__ __forceinline__ void qk_fin(f32x16& x0, f32x16& x1, const char* Ks, const bf16x8* qr, int r32, int hi, f32x16& y0, f32x16& y1, FinSt& f, const f32x16& cneg) {
  const bf16x8 k0 = *reinterpret_cast<const bf16x8*>(Ks), k1 = *reinterpret_cast<const bf16x8*>(Ks + 32 * KROW);
  qk_steps<0, NQ, FIN>(x0, x1, k0, k1, Ks, qr, r32, hi, y0, y1, f, cneg);
}
struct PsmSt { float alpha; };
template <int CH, bool FIRST> __device__ __forceinline__ void psm_chunk(f32x16& x0, f32x16& x1, float& Mx, f32x16& cneg, PsmSt& q, const float thr) {
  if constexpr (CH == 0) {
    float pm = x0[0];
#pragma unroll
    for (int r = 1; r < 16; ++r) pm = fmaxf(pm, x0[r]);
#pragma unroll
    for (int r = 0; r < 16; ++r) pm = fmaxf(pm, x1[r]);
    { auto rr = __builtin_amdgcn_permlane32_swap(__float_as_uint(pm), __float_as_uint(pm), false, false); pm = fmaxf(__uint_as_float(rr[0]), __uint_as_float(rr[1])); }
    q.alpha = 1.f;
    const bool keep = FIRST ? false : __all(pm <= thr);
    if (!keep) {
      const float d = FIRST ? pm : fmaxf(pm, 0.f);
      q.alpha = FIRST ? 0.f : __builtin_amdgcn_exp2f(-d); Mx += d;
#pragma unroll
      for (int r = 0; r < 16; ++r) { x0[r] -= d; x1[r] -= d; cneg[r] -= d; }
    }
  } else if constexpr (CH == 1) {
#pragma unroll
    for (int r = 0; r < 4; ++r) x0[r] = __builtin_amdgcn_exp2f(x0[r]);
  } else if constexpr (CH == 2) {
#pragma unroll
    for (int r = 4; r < 10; ++r) x0[r] = __builtin_amdgcn_exp2f(x0[r]);
  } else {
#pragma unroll
    for (int r = 10; r < 16; ++r) x0[r] = __builtin_amdgcn_exp2f(x0[r]);
  }
}
template <int LO, int HI, bool FIRST> __device__ __forceinline__ void psm_range(f32x16& x0, f32x16& x1, float& Mx, f32x16& cneg, PsmSt& q, const float thr) {
  if constexpr (LO < HI) { psm_chunk<LO, FIRST>(x0, x1, Mx, cneg, q, thr); psm_range<LO + 1, HI, FIRST>(x0, x1, Mx, cneg, q, thr); }
}
template <int K, int NSUB, bool PSM>
__device__ __forceinline__ void pv_blocks(f32x16* o, int vb, const FinSt& f, f32x16& x0, f32x16& x1, float& Mx, f32x16& cneg, PsmSt& q, const float thr,
                                          s16x4 l0, s16x4 h0, s16x4 l1, s16x4 h1, s16x4 l2, s16x4 h2, s16x4 l3, s16x4 h3) {
  if constexpr (K < NSUB) {
    asm volatile("s_waitcnt lgkmcnt(0)" ::: "memory"); SBAR();
#define PK(L, H) (bf16x8){L[0], L[1], L[2], L[3], H[0], H[1], H[2], H[3]}
    o[K] = __builtin_amdgcn_mfma_f32_32x32x16_bf16(f.pa0, PK(l0, h0), o[K], 0, 0, 0);
    o[K] = __builtin_amdgcn_mfma_f32_32x32x16_bf16(f.pa1, PK(l1, h1), o[K], 0, 0, 0);
    s16x4 n0 = l0, n1 = h0, n2 = l1, n3 = h1, n4 = l2, n5 = h2, n6 = l3, n7 = h3;
    if constexpr (K + 1 < NSUB) { n0 = tr_read<v_rd_off<NSUB>(K + 1, 0, 0)>(vb); n1 = tr_read<v_rd_off<NSUB>(K + 1, 0, 1)>(vb); n2 = tr_read<v_rd_off<NSUB>(K + 1, 1, 0)>(vb); n3 = tr_read<v_rd_off<NSUB>(K + 1, 1, 1)>(vb); }
    o[K] = __builtin_amdgcn_mfma_f32_32x32x16_bf16(f.pa2, PK(l2, h2), o[K], 0, 0, 0);
    o[K] = __builtin_amdgcn_mfma_f32_32x32x16_bf16(f.pa3, PK(l3, h3), o[K], 0, 0, 0);
    if constexpr (K + 1 < NSUB) { n4 = tr_read<v_rd_off<NSUB>(K + 1, 2, 0)>(vb); n5 = tr_read<v_rd_off<NSUB>(K + 1, 2, 1)>(vb); n6 = tr_read<v_rd_off<NSUB>(K + 1, 3, 0)>(vb); n7 = tr_read<v_rd_off<NSUB>(K + 1, 3, 1)>(vb); }
#undef PK
    if constexpr (PSM) {
      psm_range<(K * 4) / NSUB, ((K + 1) * 4) / NSUB, false>(x0, x1, Mx, cneg, q, thr);
      asm volatile("" : "+v"(x0), "+v"(x1));
      constexpr int NV = (NSUB == 4) ? 5 : 10;
      __builtin_amdgcn_sched_group_barrier(0x008, 1, 0); __builtin_amdgcn_sched_group_barrier(0x002, NV, 0);
      __builtin_amdgcn_sched_group_barrier(0x008, 1, 0); __builtin_amdgcn_sched_group_barrier(0x002, NV, 0);
      __builtin_amdgcn_sched_group_barrier(0x008, 1, 0); __builtin_amdgcn_sched_group_barrier(0x002, NV, 0);
      __builtin_amdgcn_sched_group_barrier(0x008, 1, 0); __builtin_amdgcn_sched_group_barrier(0x002, 2 * NV, 0);
    }
    pv_blocks<K + 1, NSUB, PSM>(o, vb, f, x0, x1, Mx, cneg, q, thr, n0, n1, n2, n3, n4, n5, n6, n7);
  }
}
template <int NSUB, bool PSM>
__device__ __forceinline__ void pv_all(f32x16* o, int vb, const FinSt& f, f32x16& x0, f32x16& x1, float& Mx, f32x16& cneg, PsmSt& q, const float thr) {
  const s16x4 l0 = tr_read<v_rd_off<NSUB>(0, 0, 0)>(vb), h0 = tr_read<v_rd_off<NSUB>(0, 0, 1)>(vb), l1 = tr_read<v_rd_off<NSUB>(0, 1, 0)>(vb), h1 = tr_read<v_rd_off<NSUB>(0, 1, 1)>(vb);
  const s16x4 l2 = tr_read<v_rd_off<NSUB>(0, 2, 0)>(vb), h2 = tr_read<v_rd_off<NSUB>(0, 2, 1)>(vb), l3 = tr_read<v_rd_off<NSUB>(0, 3, 0)>(vb), h3 = tr_read<v_rd_off<NSUB>(0, 3, 1)>(vb);
  pv_blocks<0, NSUB, PSM>(o, vb, f, x0, x1, Mx, cneg, q, thr, l0, h0, l1, h1, l2, h2, l3, h3);
}
struct AU {
  const bf16* Q; int ldq;
  const bf16* K0; int ldk0;
  const bf16* K1; int ldk1;
  const bf16* V; int ldv;
  int seq, pos0;
  float C, thr;
  const float* tc; const float* ts;
  const float* qg;
  bf16* O; int ldo;
  float* scr;
  float lam, osc; const float* subln;
};

template <int DQK, int DV, int K0C, int QMODE, int OMODE>
__device__ __forceinline__ void attn_unit(const AU& a, char* lds) {
  constexpr int NQ = DQK / 16, NSUB = DV / 32;
  int tid_ = threadIdx.x; asm volatile("" : "+v"(tid_));
  const int tid = tid_, wid = tid >> 6, lane = tid & 63, r32 = lane & 31, hi = lane >> 5;
  char* V_lds = lds; char* K_lds = lds + SHM_V;
  float* ws = (float*)(lds + LDS_WS) + wid * 64; float* li_l = ws; float* al_l = ws + 32;
  float Mx = 0.f, l_reg = 0; f32x16 o[NSUB]; bf16x8 qr[NQ]; f32x16 cneg = f32x16{};
#pragma unroll
  for (int d = 0; d < NSUB; ++d) o[d] = f32x16{};
  const float C = a.C, thr = a.thr;
  constexpr bool K1ROW = (DQK == 64);
  const int sr = tid >> 4, sc8 = tid & 15; const bool kact = K1ROW || sc8 < DQK / 8, vact = sc8 < DV / 8;
  const int ksr = K1ROW ? (tid >> 3) : sr, ksc = K1ROW ? (tid & 7) : sc8;
  const int vst0 = v_st<NSUB>(sr, sc8 * 8), vst1 = v_st<NSUB>(32 + sr, sc8 * 8);
  const int kst0 = ksr * KROW + ksc * 16, kst1 = (32 + ksr) * KROW + ksc * 16;
  const char* kfb = K_lds + r32 * KROW + hi * 16;
  const bool k1 = (K0C < DQK / 8) && ksc >= K0C; const long kld = k1 ? a.ldk1 : a.ldk0;
  const bf16* kp = (k1 ? a.K1 + (ksc - K0C) * 8 : a.K0 + ksc * 8) + (long)ksr * kld; const bf16* vp = a.V + (long)sr * a.ldv + sc8 * 8; const long vld = a.ldv;
  const int vb0 = (int)(uintptr_t)V_lds + v_rd_base(lane);
  struct { bf16x8 vs0, vs1, ks0, ks1; } sr_[2];
#define SLOAD(i, k0) do { if (DV == 128 || vact) { sr_[i].vs0 = ld8(vp + (long)(k0) * vld); sr_[i].vs1 = ld8(vp + (long)((k0) + 32) * vld); } \
    if (DQK == 128 || kact) { sr_[i].ks0 = ld8(kp + (long)(k0) * kld); if (!K1ROW) sr_[i].ks1 = ld8(kp + (long)((k0) + 32) * kld); } } while (0)
#define SWRITE(off, i) do { if (DV == 128 || vact) { *(bf16x8*)(V_lds + (off) + vst0) = sr_[i].vs0; *(bf16x8*)(V_lds + (off) + vst1) = sr_[i].vs1; } \
    if (DQK == 128 || kact) { *(bf16x8*)(K_lds + (off) + kst0) = sr_[i].ks0; if (!K1ROW) *(bf16x8*)(K_lds + (off) + kst1) = sr_[i].ks1; } } while (0)
#define SWAIT() do { if (K1ROW) asm volatile("s_waitcnt vmcnt(3)" ::: "memory"); else asm volatile("s_waitcnt vmcnt(4)" ::: "memory"); } while (0)
  SLOAD(0, 0);
  {
    const bf16* Qrow = a.Q + (long)(wid * QBLK + r32) * a.ldq; const bf16* Qw = Qrow + hi * 8; const int pos = a.pos0 + wid * QBLK + r32;
    if constexpr (QMODE == 0) {
#pragma unroll
      for (int d0 = 0; d0 < 4; ++d0) { const bf16x8 rq = ld8(Qw + d0 * 16); float yq[8];
#pragma unroll
        for (int j = 0; j < 8; ++j) yq[j] = bf2f(rq[j]) * C;
        qr[d0] = pack8(yq); }
      const bf16x8 r1 = ld8(Qw + 64), r2 = ld8(Qw + 80); float y1[8], y2[8];
      const f32x4 c0 = *(const f32x4*)(a.tc + pos * 16 + hi * 8), c1 = *(const f32x4*)(a.tc + pos * 16 + hi * 8 + 4), s0 = *(const f32x4*)(a.ts + pos * 16 + hi * 8), s1 = *(const f32x4*)(a.ts + pos * 16 + hi * 8 + 4);
#pragma unroll
      for (int j = 0; j < 8; ++j) { const float x1 = bf2f(r1[j]), x2 = bf2f(r2[j]), c = j < 4 ? c0[j & 3] : c1[j & 3], s = j < 4 ? s0[j & 3] : s1[j & 3]; y1[j] = (x1 * c - x2 * s) * C; y2[j] = (x2 * c + x1 * s) * C; }
      qr[4] = pack8(y1); qr[5] = pack8(y2);
    } else if constexpr (QMODE == 1) {
      const bf16x8 r1 = ld8(Qrow), r2 = ld8(Qrow + 8); float y[8];
      const f32x4 c0 = *(const f32x4*)(a.tc + pos * 8), c1 = *(const f32x4*)(a.tc + pos * 8 + 4), s0 = *(const f32x4*)(a.ts + pos * 8), s1 = *(const f32x4*)(a.ts + pos * 8 + 4);
#pragma unroll
      for (int j = 0; j < 8; ++j) { const float x1 = bf2f(r1[j]), x2 = bf2f(r2[j]), c = j < 4 ? c0[j & 3] : c1[j & 3], s = j < 4 ? s0[j & 3] : s1[j & 3]; y[j] = (hi ? (x2 * c + x1 * s) : (x1 * c - x2 * s)) * C; }
      qr[0] = pack8(y);
#pragma unroll
      for (int d0 = 1; d0 < 4; ++d0) { const bf16x8 rq = ld8(Qw + d0 * 16); float yq[8];
#pragma unroll
        for (int j = 0; j < 8; ++j) yq[j] = bf2f(rq[j]) * C;
        qr[d0] = pack8(yq); }
    } else {
      bf16x8 raw[8]; float ss = 0.f;
#pragma unroll
      for (int d0 = 0; d0 < 8; ++d0) raw[d0] = ld8(Qw + d0 * 16);
#pragma unroll
      for (int d0 = 0; d0 < 8; ++d0)
#pragma unroll
        for (int j = 0; j < 8; ++j) { const float f = bf2f(raw[d0][j]); ss += f * f; }
      ss += __shfl_xor(ss, 32);
      const float rs = rsqrtf(ss * (1.f / 128.f) + 1e-6f) * C;
      const int rowp = pos >> 6, colp = pos & 63;
#pragma unroll
      for (int half = 0; half < 2; ++half)
#pragma unroll
        for (int b = 0; b < 2; ++b) { const int blk = half * 4 + b, fi = b * 16 + hi * 8; const float* tcp = a.tc + (half ? colp : rowp) * 32 + fi; const float* tsp = a.ts + (half ? colp : rowp) * 32 + fi;
          const f32x4 c0 = *(const f32x4*)tcp, c1 = *(const f32x4*)(tcp + 4), s0 = *(const f32x4*)tsp, s1 = *(const f32x4*)(tsp + 4);
          const f32x4 ga0 = *(const f32x4*)(a.qg + blk * 16 + hi * 8), ga1 = *(const f32x4*)(a.qg + blk * 16 + hi * 8 + 4), gb0 = *(const f32x4*)(a.qg + (blk + 2) * 16 + hi * 8), gb1 = *(const f32x4*)(a.qg + (blk + 2) * 16 + hi * 8 + 4);
          float y1[8], y2[8];
#pragma unroll
          for (int j = 0; j < 8; ++j) { const float x1 = bf2f(raw[blk][j]) * rs * (j < 4 ? ga0[j & 3] : ga1[j & 3]), x2 = bf2f(raw[blk + 2][j]) * rs * (j < 4 ? gb0[j & 3] : gb1[j & 3]);
            const float c = j < 4 ? c0[j & 3] : c1[j & 3], s = j < 4 ? s0[j & 3] : s1[j & 3]; y1[j] = x1 * c - x2 * s; y2[j] = x2 * c + x1 * s; }
          qr[blk] = pack8(y1); qr[blk + 2] = pack8(y2); }
    }
  }
#define RESC(al) do { if (__any((al) < 1.f)) { if (hi == 0) al_l[r32] = (al); asm volatile("s_waitcnt lgkmcnt(0)" ::: "memory"); \
    _Pragma("unroll") for (int d = 0; d < NSUB; ++d) _Pragma("unroll") for (int r = 0; r < 16; ++r) o[d][r] *= al_l[crow(r, hi)]; } } while (0)
  f32x16 pA0, pA1, pB0, pB1; float mnA, mnB, alA, alB; bf16x8 pa0, pa1, pa2, pa3; const int NT = a.seq / KVBLK;
  int o_prev = 0, o_cur = 0, o_next = SLOTB;
#define ADV() do { o_prev = o_cur; o_cur = o_next; o_next = (o_next == 2 * SLOTB) ? 0 : o_next + SLOTB; } while (0)
  FinSt fs; PsmSt qs; fs.ps0 = 0.f; fs.ps1 = 0.f;
#define FIN_TAIL(al) do { float ps = fs.ps0 + fs.ps1; auto rr = __builtin_amdgcn_permlane32_swap(__float_as_uint(ps), __float_as_uint(ps), false, false); \
    ps = __uint_as_float(rr[0]) + __uint_as_float(rr[1]); l_reg = l_reg * (al) + ps; fs.ps0 = 0.f; fs.ps1 = 0.f; } while (0)
  constexpr bool ONESLOT = (DQK == 128 && DV == 128);
  asm volatile("s_waitcnt vmcnt(0)" ::: "memory"); SWRITE(0, 0);
  if constexpr (ONESLOT) { SLOAD(0, KVBLK); } else { SLOAD(1, KVBLK); if (2 < NT) SLOAD(0, 2 * KVBLK); }
  __syncthreads();
  qk_fin<NQ, false>(pA0, pA1, kfb + o_cur, qr, r32, hi, pA0, pA1, fs, cneg); SBAR();
  if constexpr (ONESLOT) { SWRITE(o_next, 0); if (2 < NT) SLOAD(0, 2 * KVBLK); } else { SWAIT(); SWRITE(o_next, 1); if (3 < NT) SLOAD(1, 3 * KVBLK); } SBAR();
  psm_range<0, 4, true>(pA0, pA1, Mx, cneg, qs, thr); alA = qs.alpha; __syncthreads(); ADV();
  int t = 1;
  for (; t + 1 < NT; t += 2) {
    SBAR(); qk_fin<NQ, true>(pB0, pB1, kfb + o_cur, qr, r32, hi, pA0, pA1, fs, cneg); FIN_TAIL(alA); SBAR();
    if constexpr (ONESLOT) { SWRITE(o_next, 0); if (t + 2 < NT) SLOAD(0, (t + 2) * KVBLK); } else { SWAIT(); SWRITE(o_next, 0); if (t + 3 < NT) SLOAD(0, (t + 3) * KVBLK); } SBAR();
    pv_all<NSUB, true>(o, vb0 + o_prev, fs, pB0, pB1, Mx, cneg, qs, thr); alB = qs.alpha;
    RESC(alB); __syncthreads(); ADV();
    SBAR(); qk_fin<NQ, true>(pA0, pA1, kfb + o_cur, qr, r32, hi, pB0, pB1, fs, cneg); FIN_TAIL(alB); SBAR();
    if constexpr (ONESLOT) { if (t + 2 < NT) SWRITE(o_next, 0); if (t + 3 < NT) SLOAD(0, (t + 3) * KVBLK); } else { if (t + 2 < NT) { SWAIT(); SWRITE(o_next, 1); } if (t + 4 < NT) SLOAD(1, (t + 4) * KVBLK); } SBAR();
    pv_all<NSUB, true>(o, vb0 + o_prev, fs, pA0, pA1, Mx, cneg, qs, thr); alA = qs.alpha;
    RESC(alA); __syncthreads(); ADV();
  }
  SBAR(); qk_fin<NQ, true>(pB0, pB1, kfb + o_cur, qr, r32, hi, pA0, pA1, fs, cneg); FIN_TAIL(alA); SBAR();
  pv_all<NSUB, true>(o, vb0 + o_prev, fs, pB0, pB1, Mx, cneg, qs, thr); alB = qs.alpha;
  RESC(alB);
  fin_range<0, 8>(pB0, pB1, fs); FIN_TAIL(alB); SBAR();
  pv_all<NSUB, false>(o, vb0 + o_cur, fs, pB0, pB1, Mx, cneg, qs, thr);
#undef ADV
#undef FIN_TAIL
  if (hi == 0) li_l[r32] = l_reg; asm volatile("s_waitcnt lgkmcnt(0)" ::: "memory");
  float rli[16];
#pragma unroll
  for (int r = 0; r < 16; ++r) rli[r] = __builtin_amdgcn_rcpf(li_l[crow(r, hi)]);
  if constexpr (OMODE == 0) {
    bf16* Ow = a.O + (long)(wid * QBLK) * a.ldo;
#pragma unroll
    for (int r = 0; r < 16; ++r) { const int orow = crow(r, hi);
#pragma unroll
      for (int d0 = 0; d0 < NSUB; ++d0) Ow[(long)orow * a.ldo + d0 * 32 + r32] = (bf16)(cvtpk(o[d0][r] * rli[r], 0.f) & 0xffffu); }
  } else if constexpr (OMODE == 1) {
    f32x4* sp = (f32x4*)(a.scr + tid * 64);
#pragma unroll
    for (int d0 = 0; d0 < NSUB; ++d0)
#pragma unroll
      for (int r4 = 0; r4 < 4; ++r4) sp[d0 * 4 + r4] = (f32x4){o[d0][4 * r4] * rli[4 * r4], o[d0][4 * r4 + 1] * rli[4 * r4 + 1], o[d0][4 * r4 + 2] * rli[4 * r4 + 2], o[d0][4 * r4 + 3] * rli[4 * r4 + 3]};
  } else {
    bf16* Ow = a.O + (long)(wid * QBLK) * a.ldo; float ssq[16];
    const f32x4* sp = (const f32x4*)(a.scr + tid * 64);
#pragma unroll
    for (int r = 0; r < 16; ++r) ssq[r] = 0.f;
#pragma unroll
    for (int d0 = 0; d0 < NSUB; ++d0)
#pragma unroll
      for (int r4 = 0; r4 < 4; ++r4) { const f32x4 q = sp[d0 * 4 + r4];
#pragma unroll
        for (int j = 0; j < 4; ++j) { const int r = 4 * r4 + j; const float v = o[d0][r] * rli[r] - a.lam * q[j]; o[d0][r] = v; ssq[r] += v * v; } }
#pragma unroll
    for (int r = 0; r < 16; ++r) {
#pragma unroll
      for (int off = 1; off < 32; off <<= 1) ssq[r] += __shfl_xor(ssq[r], off);
      ssq[r] = rsqrtf(ssq[r] * (1.f / (float)DV) + 1e-6f) * a.osc; }
    float gn[NSUB];
#pragma unroll
    for (int d0 = 0; d0 < NSUB; ++d0) gn[d0] = a.subln[d0 * 32 + r32];
#pragma unroll
    for (int r = 0; r < 16; ++r) { const int orow = crow(r, hi);
#pragma unroll
      for (int d0 = 0; d0 < NSUB; ++d0) Ow[(long)orow * a.ldo + d0 * 32 + r32] = (bf16)(cvtpk(o[d0][r] * ssq[r] * gn[d0], 0.f) & 0xffffu); }
  }
  __syncthreads();
#undef SLOAD
#undef SWRITE
#undef SWAIT
#undef RESC
}
#undef PK4
#undef KSWZ
#undef SBAR
}
#define GAS __attribute__((address_space(1)))
#define LAS __attribute__((address_space(3)))
typedef unsigned short bf16;
typedef unsigned v4u __attribute__((ext_vector_type(4)));
typedef unsigned v2u __attribute__((ext_vector_type(2)));
typedef float f32x4 __attribute__((ext_vector_type(4)));
constexpr int NWAVES = 8;
constexpr int BATCH = 8, SEQ = 4096, DM = 1024, T = BATCH * SEQ, FF = 2816;
constexpr int PROJ_LD = 2048;
constexpr int QKV_LD = 1536;
constexpr float EPS = 1e-6f;
constexpr size_t MiB = 1u << 20;
constexpr size_t WS_CTL = 0, CTL_ZERO_BYTES = 65536;
constexpr size_t WS_TAB = 1 * MiB;
constexpr size_t TAB_AC = 0, TAB_AS = 262144, TAB_BC = 524288, TAB_BS = 655360, TAB_CC = 786432, TAB_CS = 794624;
constexpr size_t WS_SSQ = 2 * MiB;
constexpr size_t WS_WIN = 4 * MiB, WS_WUQ = 8 * MiB, WS_WUKV = 9 * MiB, WS_WEO = 10 * MiB, WS_WOQKV = 12 * MiB, WS_WOO = 15 * MiB;
constexpr size_t WS_WGU0 = 17 * MiB, WS_WGU1 = 28 * MiB, WS_WDN0 = 39 * MiB, WS_WDN1 = 45 * MiB, WS_KR = 51 * MiB;
constexpr size_t WS_XN = 64 * MiB, WS_PROJ = 128 * MiB, WS_QM = 256 * MiB, WS_KVM = 304 * MiB, WS_MIX = 368 * MiB, WS_ACT = 128 * MiB, WS_SCR = 432 * MiB, WS_END = 464 * MiB;
constexpr int LDS_BYTES = 147456;

__device__ __forceinline__ unsigned f2bf(float f) { unsigned u = __builtin_bit_cast(unsigned, f); return (u + 0x7fffu + ((u >> 16) & 1u)) >> 16; }
__device__ __forceinline__ unsigned pk2(float lo, float hi) { return f2bf(lo) | (f2bf(hi) << 16); }
__device__ __forceinline__ float bf2f(unsigned b) { return __uint_as_float(b << 16); }
__device__ __forceinline__ float wave_sum(float v) {
#pragma unroll
    for (int o = 1; o < 64; o <<= 1) v += __shfl_xor(v, o);
    return v;
}
#define LDS_WAIT() asm volatile("s_waitcnt lgkmcnt(0)" ::: "memory")

__device__ __forceinline__ void transpose_item(const float* W, int K, int N, bf16* WT, int ldk, int rowmap, const float* kg, LAS float* scr, int item, int lane) {
    const int nblk = N / 32, kb = item / nblk, nb = item % nblk, k0 = 64 * kb, n0 = 32 * nb;
    int r0 = n0;
    if (rowmap == 1) r0 = n0 < 192 ? n0 : (n0 < 352 ? 256 + (n0 - 192) : 512 + (n0 - 352));
    else if (rowmap == 2) r0 = 256 * (n0 >> 7) + (n0 & 127);
    else if (rowmap == 3) r0 = 256 * (n0 >> 7) + 128 + (n0 & 127);
    float wv[32];
#pragma unroll
    for (int i = 0; i < 32; ++i) { const int kk = 2 * i + (lane >> 5); wv[i] = W[(size_t)(k0 + kk) * N + n0 + (lane & 31)]; }
    if (kg) {
#pragma unroll
        for (int i = 0; i < 32; ++i) wv[i] *= kg[k0 + 2 * i + (lane >> 5)]; }
    asm volatile("" ::: "memory");
#pragma unroll
    for (int i = 0; i < 32; ++i) { const int kk = 2 * i + (lane >> 5); scr[kk * 33 + (lane & 31)] = wv[i]; }
    LDS_WAIT(); asm volatile("" ::: "memory");
    const int c = lane & 7;
#pragma unroll
    for (int j = 0; j < 4; ++j) { const int n = (lane >> 3) + 8 * j; const LAS float* s = scr + (8 * c) * 33 + n;
        v4u o; o.x = pk2(s[0 * 33], s[1 * 33]); o.y = pk2(s[2 * 33], s[3 * 33]); o.z = pk2(s[4 * 33], s[5 * 33]); o.w = pk2(s[6 * 33], s[7 * 33]);
        *(v4u*)(WT + (size_t)(r0 + n) * ldk + k0 + 8 * c) = o; }
    LDS_WAIT(); asm volatile("" ::: "memory");
}
__device__ __forceinline__ void rms_row_to_bf16(const float* xrow, const float* g, bf16* orow, int lane) {
    const f32x4* xr = (const f32x4*)xrow + lane; const f32x4* gr = (const f32x4*)g + lane;
    f32x4 v[4]; float s = 0.f;
#pragma unroll
    for (int j = 0; j < 4; ++j) { v[j] = xr[64 * j]; s += (v[j].x * v[j].x + v[j].y * v[j].y) + (v[j].z * v[j].z + v[j].w * v[j].w); }
    const float rs = rsqrtf(wave_sum(s) * (1.f / DM) + EPS);
    unsigned long long* o8 = (unsigned long long*)orow + lane;
#pragma unroll
    for (int j = 0; j < 4; ++j) { const f32x4 gg = gr[64 * j]; o8[64 * j] = (unsigned long long)pk2(v[j].x * rs * gg.x, v[j].y * rs * gg.y) | ((unsigned long long)pk2(v[j].z * rs * gg.z, v[j].w * rs * gg.w) << 32); }
}
__device__ __forceinline__ void rms_row_f32(float* xrow, const float* g, int lane) {
    f32x4* xr = (f32x4*)xrow + lane; const f32x4* gr = (const f32x4*)g + lane;
    f32x4 v[4]; float s = 0.f;
#pragma unroll
    for (int j = 0; j < 4; ++j) { v[j] = xr[64 * j]; s += (v[j].x * v[j].x + v[j].y * v[j].y) + (v[j].z * v[j].z + v[j].w * v[j].w); }
    const float rs = rsqrtf(wave_sum(s) * (1.f / DM) + EPS);
#pragma unroll
    for (int j = 0; j < 4; ++j) { const f32x4 gg = gr[64 * j]; xr[64 * j] = v[j] * rs * gg; }
}

__device__ __forceinline__ void rms_rows2_to_bf16(const float* xa, const float* xb, const float* g, bf16* oa, bf16* ob, int lane) {
    const f32x4* ra = (const f32x4*)xa + lane; const f32x4* rb = (const f32x4*)xb + lane; const f32x4* gr = (const f32x4*)g + lane;
    f32x4 va[4], vb[4]; float sa = 0.f, sb = 0.f;
#pragma unroll
    for (int j = 0; j < 4; ++j) { va[j] = ra[64 * j]; vb[j] = rb[64 * j]; }
#pragma unroll
    for (int j = 0; j < 4; ++j) { sa += (va[j].x * va[j].x + va[j].y * va[j].y) + (va[j].z * va[j].z + va[j].w * va[j].w); sb += (vb[j].x * vb[j].x + vb[j].y * vb[j].y) + (vb[j].z * vb[j].z + vb[j].w * vb[j].w); }
    const float rsa = rsqrtf(wave_sum(sa) * (1.f / DM) + EPS), rsb = rsqrtf(wave_sum(sb) * (1.f / DM) + EPS);
    unsigned long long* pa = (unsigned long long*)oa + lane; unsigned long long* pb = (unsigned long long*)ob + lane;
#pragma unroll
    for (int j = 0; j < 4; ++j) { const f32x4 gg = gr[64 * j];
        pa[64 * j] = (unsigned long long)pk2(va[j].x * rsa * gg.x, va[j].y * rsa * gg.y) | ((unsigned long long)pk2(va[j].z * rsa * gg.z, va[j].w * rsa * gg.w) << 32);
        pb[64 * j] = (unsigned long long)pk2(vb[j].x * rsb * gg.x, vb[j].y * rsb * gg.y) | ((unsigned long long)pk2(vb[j].z * rsb * gg.z, vb[j].w * rsb * gg.w) << 32); }
}
__device__ __forceinline__ void rms_rows2_f32(float* xa, float* xb, const float* g, int lane) {
    f32x4* ra = (f32x4*)xa + lane; f32x4* rb = (f32x4*)xb + lane; const f32x4* gr = (const f32x4*)g + lane;
    f32x4 va[4], vb[4]; float sa = 0.f, sb = 0.f;
#pragma unroll
    for (int j = 0; j < 4; ++j) { va[j] = ra[64 * j]; vb[j] = rb[64 * j]; }
#pragma unroll
    for (int j = 0; j < 4; ++j) { sa += (va[j].x * va[j].x + va[j].y * va[j].y) + (va[j].z * va[j].z + va[j].w * va[j].w); sb += (vb[j].x * vb[j].x + vb[j].y * vb[j].y) + (vb[j].z * vb[j].z + vb[j].w * vb[j].w); }
    const float rsa = rsqrtf(wave_sum(sa) * (1.f / DM) + EPS), rsb = rsqrtf(wave_sum(sb) * (1.f / DM) + EPS);
#pragma unroll
    for (int j = 0; j < 4; ++j) { const f32x4 gg = gr[64 * j]; ra[64 * j] = va[j] * rsa * gg; rb[64 * j] = vb[j] * rsb * gg; }
}
__device__ __forceinline__ void rms_rows4_to_bf16(const float* x, const float* g, bf16* o, int m, int stride, int lane) {
    f32x4 v[4][4]; float rs[4];
#pragma unroll
    for (int t = 0; t < 4; ++t) { const f32x4* r = (const f32x4*)(x + (size_t)(m + t * stride) * DM) + lane;
#pragma unroll
        for (int j = 0; j < 4; ++j) v[t][j] = r[64 * j]; }
    asm volatile("" ::: "memory");
#pragma unroll
    for (int t = 0; t < 4; ++t) { float s = 0.f;
#pragma unroll
        for (int j = 0; j < 4; ++j) s += (v[t][j].x * v[t][j].x + v[t][j].y * v[t][j].y) + (v[t][j].z * v[t][j].z + v[t][j].w * v[t][j].w);
        rs[t] = rsqrtf(wave_sum(s) * (1.f / DM) + EPS); }
    const f32x4* gr = (const f32x4*)g + lane;
#pragma unroll
    for (int j = 0; j < 4; ++j) { const f32x4 gg = gr[64 * j];
#pragma unroll
        for (int t = 0; t < 4; ++t) { unsigned long long* po = (unsigned long long*)(o + (size_t)(m + t * stride) * DM) + lane;
            po[64 * j] = (unsigned long long)pk2(v[t][j].x * rs[t] * gg.x, v[t][j].y * rs[t] * gg.y) | ((unsigned long long)pk2(v[t][j].z * rs[t] * gg.z, v[t][j].w * rs[t] * gg.w) << 32); } }
}
__device__ __forceinline__ void rows4_to_bf16_ssq(const float* x, bf16* o, float* ssq, int m, int stride, int lane) {
    f32x4 v[4][4];
#pragma unroll
    for (int t = 0; t < 4; ++t) { const f32x4* r = (const f32x4*)(x + (size_t)(m + t * stride) * DM) + lane;
#pragma unroll
        for (int j = 0; j < 4; ++j) v[t][j] = r[64 * j]; }
    asm volatile("" ::: "memory");
#pragma unroll
    for (int t = 0; t < 4; ++t) { float s = 0.f;
#pragma unroll
        for (int j = 0; j < 4; ++j) s += (v[t][j].x * v[t][j].x + v[t][j].y * v[t][j].y) + (v[t][j].z * v[t][j].z + v[t][j].w * v[t][j].w);
        s = wave_sum(s); if (lane == 0) ssq[m + t * stride] = s; }
#pragma unroll
    for (int j = 0; j < 4; ++j)
#pragma unroll
        for (int t = 0; t < 4; ++t) { unsigned long long* po = (unsigned long long*)(o + (size_t)(m + t * stride) * DM) + lane;
            po[64 * j] = (unsigned long long)pk2(v[t][j].x, v[t][j].y) | ((unsigned long long)pk2(v[t][j].z, v[t][j].w) << 32); }
}
#define XB_TMO      128
#define XB_XCNT(j)  (256  + 64 * (j))
#define XB_XSUB(j)  (1280 + 64 * (j))
#define XB_XGEN(j)  (2304 + 64 * (j))
#define XB_TOP      3328
#define XB_TOPGEN   3392
#define XCD_BAR_WORDS 3456
#define XB_SPIN_CAP (1u << 18)
#define LAS __attribute__((address_space(3)))

__device__ __forceinline__ unsigned xb_ld(unsigned* p)              { return __hip_atomic_load(p, __ATOMIC_RELAXED, __HIP_MEMORY_SCOPE_AGENT); }
__device__ __forceinline__ unsigned xb_add(unsigned* p, unsigned v) { return __hip_atomic_fetch_add(p, v, __ATOMIC_RELAXED, __HIP_MEMORY_SCOPE_AGENT); }
__device__ __forceinline__ unsigned xb_xcc_id() { return (unsigned)__builtin_amdgcn_s_getreg((3 << 11) | 20) & 0xFu; }
#define XB_SPIN(cond, bar) do { unsigned _sp = 0; while (cond) { __builtin_amdgcn_s_sleep(1); \
    if ((++_sp & 255u) == 0u) { if (xb_ld(&(bar)[XB_TMO])) break; if (_sp > XB_SPIN_CAP) { atomicAdd(&(bar)[XB_TMO], 1u); break; } } } } while (0)

struct XcdBarrier {
    unsigned* bar; unsigned x;
    volatile LAS unsigned* st;
};

__device__ __forceinline__ XcdBarrier xcd_barrier_post(unsigned* bar, volatile LAS unsigned* st) {
    XcdBarrier b; b.bar = bar; b.x = xb_xcc_id(); b.st = st;
    if (threadIdx.x == 0) (void)xb_add(&bar[XB_XCNT(b.x)], 1u);
    return b;
}
__device__ __forceinline__ void xcd_barrier_complete(unsigned* bar, unsigned x, unsigned& nloc, unsigned& nx) {
    const unsigned G = gridDim.x * gridDim.y * gridDim.z;
    unsigned sum, cnt, mine, sp = 0u;
    for (;;) {
        sum = 0u; cnt = 0u; mine = 0u;
#pragma unroll
        for (unsigned j = 0; j < 16; ++j) { const unsigned c = xb_ld(&bar[XB_XCNT(j)]); sum += c; cnt += (c > 0u) ? 1u : 0u; mine = (j == x) ? c : mine; }
        if (sum == G) break;
        __builtin_amdgcn_s_sleep(1);
        if ((++sp & 255u) == 0u) { if (xb_ld(&bar[XB_TMO])) break; if (sp > XB_SPIN_CAP) { atomicAdd(&bar[XB_TMO], 1u); break; } }
    }
    nloc = mine > 0u ? mine : 1u; nx = cnt > 0u ? cnt : 1u;
}

__device__ __forceinline__ void xcd_barrier(const XcdBarrier& b) {
    asm volatile("s_waitcnt vmcnt(0)" ::: "memory");
    __syncthreads();
    if (threadIdx.x == 0) {
        unsigned* bar = b.bar;
        __builtin_amdgcn_s_waitcnt(0);
        unsigned nloc = b.st[0], nx = b.st[1];
        if (nloc == 0u) { xcd_barrier_complete(bar, b.x, nloc, nx); b.st[0] = nloc; b.st[1] = nx; }
        const unsigned old = xb_add(&bar[XB_XSUB(b.x)], 1u);
        const unsigned gen = old / nloc;
        if (old + 1u == (gen + 1u) * nloc) {
            __builtin_amdgcn_fence(__ATOMIC_RELEASE, "agent");
            asm volatile("s_waitcnt vmcnt(0)" ::: "memory");
            const unsigned og = xb_add(&bar[XB_TOP], 1u);
            const unsigned tg = og / nx;
            if (og + 1u == (tg + 1u) * nx) xb_add(&bar[XB_TOPGEN], 1u);
            else XB_SPIN(xb_ld(&bar[XB_TOPGEN]) == tg, bar);
            __builtin_amdgcn_fence(__ATOMIC_ACQUIRE, "agent");
            xb_add(&bar[XB_XGEN(b.x)], 1u);
            asm volatile("s_waitcnt vmcnt(0)" ::: "memory");
        } else {
            XB_SPIN(xb_ld(&bar[XB_XGEN(b.x)]) == gen, bar);
            __builtin_amdgcn_fence(__ATOMIC_ACQUIRE, "agent");
            asm volatile("s_waitcnt vmcnt(0)" ::: "memory");
        }
    }
    __syncthreads();
}

struct Params { const float* in[23]; float* out; unsigned char* ws; int ph_lo, ph_hi, coop_keep, pad; };
constexpr int N_PHASES = 14;

__global__ void __launch_bounds__(NWAVES * 64, 2) fwd_mega(Params p) {
    extern __shared__ __attribute__((aligned(16))) unsigned char lds[];
    cg::grid_group grid = cg::this_grid();
    const int tid = threadIdx.x, lane = tid & 63, wave = __builtin_amdgcn_readfirstlane(tid >> 6);
    const int G = gridDim.x, bx = blockIdx.x;
    const int gw = bx * NWAVES + wave, NGW = G * NWAVES;
    unsigned char* ws = p.ws;
    LAS unsigned char* ldsl = (LAS unsigned char*)lds;
    const float* tAc = (const float*)(ws + WS_TAB + TAB_AC); const float* tAs = (const float*)(ws + WS_TAB + TAB_AS);
    const float* tBc = (const float*)(ws + WS_TAB + TAB_BC); const float* tBs = (const float*)(ws + WS_TAB + TAB_BS);
    const float* tCc = (const float*)(ws + WS_TAB + TAB_CC); const float* tCs = (const float*)(ws + WS_TAB + TAB_CS);
    float* ssq_q = (float*)(ws + WS_SSQ); float* ssq_kv = ssq_q + T; float* ssq_h1 = ssq_q + 2 * T; float* ssq_h2 = ssq_q + 3 * T; float* ssq_h3 = ssq_q + 4 * T; float* ssq_h4 = ssq_q + 5 * T; float* ssq_x = ssq_q + 6 * T;
    bf16* W_in = (bf16*)(ws + WS_WIN); bf16* W_uq = (bf16*)(ws + WS_WUQ); bf16* W_ukv = (bf16*)(ws + WS_WUKV); bf16* W_eo = (bf16*)(ws + WS_WEO);
    bf16* W_oqkv = (bf16*)(ws + WS_WOQKV); bf16* W_oo = (bf16*)(ws + WS_WOO);
    bf16* KR = (bf16*)(ws + WS_KR); bf16* XN = (bf16*)(ws + WS_XN); bf16* PROJ = (bf16*)(ws + WS_PROJ); bf16* QM = (bf16*)(ws + WS_QM); bf16* KVM = (bf16*)(ws + WS_KVM);
    bf16* MIX = (bf16*)(ws + WS_MIX); bf16* ACT = (bf16*)(ws + WS_ACT);
    float* HID = p.out;
    const int lo = p.ph_lo, hi = p.ph_hi;
    volatile LAS unsigned* bst = (volatile LAS unsigned*)(ldsl + 131072 + 64);
    if (tid < 2) bst[tid] = 0u;
    __syncthreads();
    XcdBarrier bar; bar.bar = (unsigned*)(ws + WS_CTL); bar.x = 0; bar.st = bst;
    if (hi - lo > 1) bar = xcd_barrier_post((unsigned*)(ws + WS_CTL), bst);
#ifndef PHMASK
#define PHMASK 0x3fff
#endif
#define IN(k) (((PHMASK >> (k)) & 1) && lo <= (k) && (k) < hi)
#ifndef DUPMASK
#define DUPMASK 0
#endif
#define REP(k) for (int rep_ = 0; rep_ < 1 + ((DUPMASK >> (k)) & 1); ++rep_)
#define SEAM(k) do { if (IN(k) && IN((k) + 1)) { if (p.coop_keep != 0) grid.sync();   xcd_barrier(bar); } } while (0)
#define GEMM_PHASE(EPI, E, Aptr, lda_, Bptr, ldb_, N_, K_) do { pg8::Gemm g{(const pg8::bf16_t*)(Aptr), (const pg8::bf16_t*)(Bptr), (lda_), (ldb_), T, (N_), (K_)}; \
        pg8::StaticOrder S; S.init(T, (N_), G, bx); pg8::gemm_phase<EPI, pg8::StaticOrder, true, true>(ldsl, g, S, E); } while (0)

    if (IN(0)) REP(0) {
        LAS float* scr = (LAS float*)(ldsl + wave * 16384);
        constexpr int I_IN = 16 * 59, I_UQ = 3 * 24, I_UKV = 2 * 32, I_SQ = 16 * 32, I_OQKV = 16 * 48, I_GU = 16 * 88, I_DN = 44 * 32;
        constexpr int NITEMS = I_IN + I_UQ + I_UKV + 2 * I_SQ + I_OQKV + 4 * I_GU + 2 * I_DN;
        for (int it = gw; it < NITEMS; it += NGW) {
            int r = it;
            if (r < I_IN) { transpose_item(p.in[2], 1024, 1888, W_in, 1024, 1, p.in[1], scr, r, lane); continue; } r -= I_IN;
            if (r < I_UQ) { transpose_item(p.in[4], 192, 768, W_uq, 256, 0, p.in[3], scr, r, lane); continue; } r -= I_UQ;
            if (r < I_UKV) { transpose_item(p.in[6], 128, 1024, W_ukv, 256, 0, p.in[5], scr, r, lane); continue; } r -= I_UKV;
            if (r < I_SQ) { transpose_item(p.in[12], 1024, 1024, W_eo, 1024, 0, nullptr, scr, r, lane); continue; } r -= I_SQ;
            if (r < I_SQ) { transpose_item(p.in[17], 1024, 1024, W_oo, 1024, 0, nullptr, scr, r, lane); continue; } r -= I_SQ;
            if (r < I_OQKV) { transpose_item(p.in[14], 1024, 1536, W_oqkv, 1024, 0, p.in[13], scr, r, lane); continue; } r -= I_OQKV;
            if (r < 4 * I_GU) { const int q = r / I_GU, l = q >> 1, up = q & 1; r -= q * I_GU;
                transpose_item(p.in[up ? 20 : 19] + (size_t)l * 1024 * FF, 1024, FF, (bf16*)(ws + (l ? WS_WGU1 : WS_WGU0)), 1024, up ? 3 : 2, p.in[18] + l * DM, scr, r, lane); continue; } r -= 4 * I_GU;
            { const int l = r / I_DN; r -= l * I_DN; transpose_item(p.in[21] + (size_t)l * FF * 1024, FF, 1024, (bf16*)(ws + (l ? WS_WDN1 : WS_WDN0)), FF, 0, nullptr, scr, r, lane); }
        }
        const int gt = bx * (NWAVES * 64) + tid, NGT = G * NWAVES * 64;
        for (int i = gt; i < (64 + 96) * 128; i += NGT) { const int rr = i >> 7, c8 = i & 127, row = rr < 64 ? 192 + rr : 416 + (rr - 64); *(v4u*)(W_in + (size_t)row * 1024 + c8 * 8) = (v4u){0u, 0u, 0u, 0u}; }
        for (int i = gt; i < 768 * 8; i += NGT) { const int row = i >> 3, c8 = i & 7; *(v4u*)(W_uq + (size_t)row * 256 + 192 + c8 * 8) = (v4u){0u, 0u, 0u, 0u}; }
        for (int i = gt; i < 1024 * 16; i += NGT) { const int row = i >> 4, c8 = i & 15; *(v4u*)(W_ukv + (size_t)row * 256 + 128 + c8 * 8) = (v4u){0u, 0u, 0u, 0u}; }
        for (int i = gt; i < 6 * T / 4; i += NGT) ((f32x4*)ssq_q)[i] = (f32x4){0.f, 0.f, 0.f, 0.f};
        for (int i = gt; i < 4096 * 16; i += NGT) { const int pos = i >> 4, f = i & 15; const float inv = exp2f(-(float)(2 * f) * (1.f / 32.f) * 18.931568569324174f); float s, c; sincosf((float)pos * inv, &s, &c); ((float*)tAc)[i] = c; ((float*)tAs)[i] = s; }
        for (int i = gt; i < 4096 * 8; i += NGT) { const int pos = i >> 3, f = i & 7; const float inv = exp2f(-(float)(2 * f) * (1.f / 16.f) * 18.931568569324174f); float s, c; sincosf((float)pos * inv, &s, &c); ((float*)tBc)[i] = c; ((float*)tBs)[i] = s; }
        for (int i = gt; i < 64 * 32; i += NGT) { const int pos = i >> 5, f = i & 31; const float inv = exp2f(-(float)(2 * f) * (1.f / 64.f) * 13.287712379549449f); float s, c; sincosf((float)pos * inv, &s, &c); ((float*)tCc)[i] = c; ((float*)tCs)[i] = s; }
        for (int m = gw; m < T; m += 4 * NGW) rows4_to_bf16_ssq(p.in[0], XN, ssq_x, m, NGW, lane);
        __syncthreads();
    }
    SEAM(0);
    if (IN(1)) REP(1) { pg8::EpiInProj E{PROJ, PROJ_LD, ssq_q, T, ssq_x, 1.f / DM}; GEMM_PHASE(pg8::EpiInProj, E, XN, DM, W_in, DM, PROJ_LD, DM); }
    SEAM(1);
    if (IN(2)) REP(2) {
        for (int m = gw; m < T; m += 4 * NGW) {
            float a1[4], a2[4], b1[4], b2[4], ca[4], sa[4], cb[4], sb[4];
            const int blk = lane >> 3, i = lane & 7, l16 = lane & 15;
#pragma unroll
            for (int t = 0; t < 4; ++t) { const int mm = m + t * NGW; const bf16* row = PROJ + (size_t)mm * PROJ_LD; const int pos = mm & (SEQ - 1);
                a1[t] = bf2f(row[384 + l16]); a2[t] = bf2f(row[384 + 16 + l16]); ca[t] = tAc[pos * 16 + l16]; sa[t] = tAs[pos * 16 + l16];
                b1[t] = bf2f(row[1024 + blk * 64 + i]); b2[t] = bf2f(row[1024 + blk * 64 + i + 8]); cb[t] = tBc[pos * 8 + i]; sb[t] = tBs[pos * 8 + i]; }
            asm volatile("" ::: "memory");
#pragma unroll
            for (int t = 0; t < 4; ++t) { const int mm = m + t * NGW; bf16* row = PROJ + (size_t)mm * PROJ_LD;
                if (lane < 16) { KR[(size_t)mm * 32 + lane] = (bf16)f2bf(a1[t] * ca[t] - a2[t] * sa[t]); KR[(size_t)mm * 32 + 16 + lane] = (bf16)f2bf(a2[t] * ca[t] + a1[t] * sa[t]); }
                bf16* kd = row + 1024 + blk * 64; kd[i] = (bf16)f2bf(b1[t] * cb[t] - b2[t] * sb[t]); kd[i + 8] = (bf16)f2bf(b2[t] * cb[t] + b1[t] * sb[t]); }
        }
        { pg8::EpiBf16S E{QM, 768, ssq_q, 1.f / 192.f}; GEMM_PHASE(pg8::EpiBf16S, E, PROJ, PROJ_LD, W_uq, 256, 768, 256); }
        { pg8::EpiBf16S E{KVM, 1024, ssq_kv, 1.f / 128.f}; GEMM_PHASE(pg8::EpiBf16S, E, PROJ + 256, PROJ_LD, W_ukv, 256, 1024, 256); }
    }
    SEAM(2);
    if (IN(3)) REP(3) {
        const int xcd = bx & 7, loc = bx >> 3;
#ifndef NO_MLA
        for (int i = 0; (i * G + bx) < 1024; ++i) {
            int u = i * G + bx, bh, qb;
            if (G == 256) { bh = i * 16 + xcd * 2 + (loc >> 4); qb = loc & 15; } else { bh = u >> 4; qb = u & 15; }
            const int b = bh >> 3, h = bh & 7; const size_t tok0 = (size_t)b * SEQ;
            att::AU a;
            a.Q = QM + (tok0 + qb * 256) * 768 + h * 96; a.ldq = 768;
            a.K0 = KVM + tok0 * 1024 + h * 128; a.ldk0 = 1024; a.K1 = KR + tok0 * 32; a.ldk1 = 32;
            a.V = KVM + tok0 * 1024 + h * 128 + 64; a.ldv = 1024; a.seq = SEQ; a.pos0 = qb * 256;
            a.C = 0.10206207261596575f * 1.4426950408889634f; a.thr = 8.f * 1.4426950408889634f; a.tc = tAc; a.ts = tAs; a.qg = nullptr;
            a.O = MIX + (tok0 + qb * 256) * 1024 + h * 64; a.ldo = 1024; a.scr = nullptr; a.lam = 0.f; a.osc = 1.f; a.subln = nullptr;
            att::attn_unit<96, 64, 8, 0, 0>(a, (char*)lds);
        }
#endif
#ifndef NO_DIFF
        float lam;
        { const float a1 = p.in[7][lane] * p.in[8][lane], a2 = p.in[9][lane] * p.in[10][lane]; lam = __expf(wave_sum(a1)) - __expf(wave_sum(a2)) + 0.2f; }
        for (int i = 0; (i * G + bx) < 512; ++i) {
            int u = i * G + bx, bh, qb;
            if (G == 256) { bh = i * 16 + xcd * 2 + (loc >> 4); qb = loc & 15; } else { bh = u >> 4; qb = u & 15; }
            const int b = bh >> 2, h = bh & 3; const size_t tok0 = (size_t)b * SEQ;
            att::AU a;
            a.ldq = PROJ_LD; a.ldk0 = PROJ_LD; a.K1 = nullptr; a.ldk1 = 0; a.V = PROJ + tok0 * PROJ_LD + 1536 + h * 128; a.ldv = PROJ_LD; a.seq = SEQ; a.pos0 = qb * 256;
            a.C = 0.125f * 1.4426950408889634f; a.thr = 8.f * 1.4426950408889634f; a.tc = tBc; a.ts = tBs; a.qg = nullptr;
            a.O = MIX + (tok0 + qb * 256) * 1024 + 512 + h * 128; a.ldo = 1024; a.scr = (float*)(ws + WS_SCR) + (size_t)bx * 32768; a.lam = lam; a.osc = 0.8f; a.subln = p.in[11];
            a.Q = PROJ + (tok0 + qb * 256) * PROJ_LD + 512 + h * 128 + 64; a.K0 = PROJ + tok0 * PROJ_LD + 1024 + h * 128 + 64;
#ifndef NO_D1
            att::attn_unit<64, 128, 8, 1, 1>(a, (char*)lds);
#endif
#ifndef NO_D2
            a.Q -= 64; a.K0 -= 64;
            att::attn_unit<64, 128, 8, 1, 2>(a, (char*)lds);
#endif
        }
#endif
    }
    SEAM(3);
    if (IN(4)) REP(4) { pg8::EpiResB<false> E{nullptr, XN, DM, ssq_h1}; GEMM_PHASE(pg8::EpiResB<false>, E, MIX, DM, W_eo, DM, DM, DM); }
    SEAM(4);
    if (IN(5)) REP(5) { pg8::EpiSwiGLU E{ACT, FF, ssq_h1, 1.f / DM}; GEMM_PHASE(pg8::EpiSwiGLU, E, XN, DM, ws + WS_WGU0, DM, 2 * FF, DM); }
    SEAM(5);
    if (IN(6)) REP(6) { pg8::EpiResB<false> E{nullptr, XN, DM, ssq_h2}; GEMM_PHASE(pg8::EpiResB<false>, E, ACT, FF, ws + WS_WDN0, FF, DM, FF); }
    SEAM(6);
    if (IN(7)) REP(7) { pg8::EpiBf16S E{PROJ, QKV_LD, ssq_h2, 1.f / DM}; GEMM_PHASE(pg8::EpiBf16S, E, XN, DM, W_oqkv, DM, QKV_LD, DM); }
    SEAM(7);
    if (IN(8)) REP(8) {
        const int hd = lane >> 5, li = lane & 31;
        const float g0 = p.in[16][li], g1 = p.in[16][li + 32], g2 = p.in[16][li + 64], g3 = p.in[16][li + 96];
        for (int m = gw; m < T; m += 4 * NGW) {
            float x0[4], x1[4], x2[4], x3[4];
#pragma unroll
            for (int t = 0; t < 4; ++t) { const bf16* kh = PROJ + (size_t)(m + t * NGW) * QKV_LD + 1024 + hd * 128; x0[t] = bf2f(kh[li]); x1[t] = bf2f(kh[li + 32]); x2[t] = bf2f(kh[li + 64]); x3[t] = bf2f(kh[li + 96]); }
            asm volatile("" ::: "memory");
#pragma unroll
            for (int t = 0; t < 4; ++t) { const int mm = m + t * NGW; bf16* kh = PROJ + (size_t)mm * QKV_LD + 1024 + hd * 128; const int pos = mm & (SEQ - 1), rowp = pos >> 6, colp = pos & 63;
                float ss = (x0[t] * x0[t] + x1[t] * x1[t]) + (x2[t] * x2[t] + x3[t] * x3[t]);
#pragma unroll
                for (int o = 1; o < 32; o <<= 1) ss += __shfl_xor(ss, o);
                const float rs = rsqrtf(ss * (1.f / 128.f) + EPS);
                const float y0 = x0[t] * rs * g0, y1 = x1[t] * rs * g1, y2 = x2[t] * rs * g2, y3 = x3[t] * rs * g3;
                const float cr = tCc[rowp * 32 + li], sr = tCs[rowp * 32 + li], cc = tCc[colp * 32 + li], sc = tCs[colp * 32 + li];
                kh[li] = (bf16)f2bf(y0 * cr - y1 * sr); kh[li + 32] = (bf16)f2bf(y1 * cr + y0 * sr); kh[li + 64] = (bf16)f2bf(y2 * cc - y3 * sc); kh[li + 96] = (bf16)f2bf(y3 * cc + y2 * sc); }
        }
    }
    SEAM(8);
    if (IN(9)) REP(9) {
        const int xcd = bx & 7, loc = bx >> 3;
        for (int i = 0; (i * G + bx) < 1024; ++i) {
            int u = i * G + bx, bh, qb;
            if (G == 256) { bh = i * 16 + xcd * 2 + (loc >> 4); qb = loc & 15; } else { bh = u >> 4; qb = u & 15; }
            const int b = bh >> 3, h = bh & 7, kvh = h >> 2; const size_t tok0 = (size_t)b * SEQ;
            att::AU a;
            a.Q = PROJ + (tok0 + qb * 256) * QKV_LD + h * 128; a.ldq = QKV_LD;
            a.K0 = PROJ + tok0 * QKV_LD + 1024 + kvh * 128; a.ldk0 = QKV_LD; a.K1 = nullptr; a.ldk1 = 0;
            a.V = PROJ + tok0 * QKV_LD + 1280 + kvh * 128; a.ldv = QKV_LD; a.seq = SEQ; a.pos0 = qb * 256;
            a.C = 0.08838834764831845f * 1.4426950408889634f; a.thr = 8.f * 1.4426950408889634f; a.tc = tCc; a.ts = tCs; a.qg = p.in[15];
            a.O = MIX + (tok0 + qb * 256) * 1024 + h * 128; a.ldo = 1024; a.scr = nullptr; a.lam = 0.f; a.osc = 1.f; a.subln = nullptr;
            att::attn_unit<128, 128, 16, 2, 0>(a, (char*)lds);
        }
    }
    SEAM(9);
    if (IN(10)) REP(10) { pg8::EpiResB<false> E{nullptr, XN, DM, ssq_h3}; GEMM_PHASE(pg8::EpiResB<false>, E, MIX, DM, W_oo, DM, DM, DM); }
    SEAM(10);
    if (IN(11)) REP(11) { pg8::EpiSwiGLU E{ACT, FF, ssq_h3, 1.f / DM}; GEMM_PHASE(pg8::EpiSwiGLU, E, XN, DM, ws + WS_WGU1, DM, 2 * FF, DM); }
    SEAM(11);
    if (IN(12)) REP(12) { pg8::EpiResB<false> E{nullptr, XN, DM, ssq_h4}; GEMM_PHASE(pg8::EpiResB<false>, E, ACT, FF, ws + WS_WDN1, FF, DM, FF); }
    SEAM(12);
    if (IN(13)) REP(13) {
        for (int m = gw; m < T; m += 4 * NGW) {
            v2u w[4][4]; float rs[4]; const f32x4* gr = (const f32x4*)p.in[22] + lane;
#pragma unroll
            for (int t = 0; t < 4; ++t) { const v2u* h = (const v2u*)(XN + (size_t)(m + t * NGW) * DM) + lane; rs[t] = ssq_h4[m + t * NGW];
#pragma unroll
                for (int j = 0; j < 4; ++j) w[t][j] = h[64 * j]; }
#pragma unroll
            for (int t = 0; t < 4; ++t) rs[t] = rsqrtf(rs[t] * (1.f / DM) + EPS);
#pragma unroll
            for (int j = 0; j < 4; ++j) { const f32x4 gg = gr[64 * j];
#pragma unroll
                for (int t = 0; t < 4; ++t) { f32x4* o = (f32x4*)(HID + (size_t)(m + t * NGW) * DM) + lane;
                    o[64 * j] = (f32x4){bf2f(w[t][j].x & 0xffffu), bf2f(w[t][j].x >> 16), bf2f(w[t][j].y & 0xffffu), bf2f(w[t][j].y >> 16)} * rs[t] * gg; } }
        }
    }
#undef IN
#undef SEAM
#undef GEMM_PHASE
}

#ifndef MK_PER_PHASE
#define MK_PER_PHASE 0
#endif
extern "C" void kernel_launch(void* const* d_in, const int* in_sizes, int n_in, void* d_out, int out_size, void* d_ws, size_t ws_size, hipStream_t stream) {
    static int grid = 0;
    if (grid == 0) {
        if (n_in != 23 || in_sizes[0] != T * DM || out_size != T * DM || ws_size < WS_END) { fprintf(stderr, "kernel_launch: shape mismatch (n_in %d in0 %d out %d ws %zu)\n", n_in, n_in > 0 ? in_sizes[0] : -1, out_size, ws_size); grid = -1; return; }
        int dev = 0, cus = 0, per_cu = 0;
        if (hipGetDevice(&dev) != hipSuccess || hipDeviceGetAttribute(&cus, hipDeviceAttributeMultiprocessorCount, dev) != hipSuccess) { grid = -1; return; }
        if (hipFuncSetAttribute((const void*)fwd_mega, hipFuncAttributeMaxDynamicSharedMemorySize, LDS_BYTES) != hipSuccess) { fprintf(stderr, "kernel_launch: hipFuncSetAttribute failed\n"); grid = -1; return; }
        if (hipOccupancyMaxActiveBlocksPerMultiprocessor(&per_cu, (const void*)fwd_mega, NWAVES * 64, LDS_BYTES) != hipSuccess || per_cu < 1) { fprintf(stderr, "kernel_launch: occupancy query says %d\n", per_cu); per_cu = 1; }
        (void)hipGetLastError();
        grid = cus;
    }
    if (grid < 0) return;
    if (hipMemsetAsync((char*)d_ws + WS_CTL, 0, CTL_ZERO_BYTES, stream) != hipSuccess) { fprintf(stderr, "kernel_launch: memset failed\n"); return; }
    Params p{};
    for (int i = 0; i < 23; ++i) p.in[i] = (const float*)d_in[i];
    p.out = (float*)d_out; p.ws = (unsigned char*)d_ws;
#if MK_PER_PHASE
    for (int k = 0; k < N_PHASES; ++k) { p.ph_lo = k; p.ph_hi = k + 1; hipLaunchKernelGGL(fwd_mega, dim3(grid), dim3(NWAVES * 64), LDS_BYTES, stream, p); }
#else
    p.ph_lo = 0; p.ph_hi = N_PHASES;
    void* args[] = {&p};
    hipError_t e = hipLaunchCooperativeKernel((const void*)fwd_mega, dim3(grid), dim3(NWAVES * 64), args, LDS_BYTES, stream);
    if (e != hipSuccess) fprintf(stderr, "kernel_launch: cooperative launch failed: %s (grid %d)\n", hipGetErrorString(e), grid);
#endif
}
```
